# Optimizing an MI355X kernel written in HIP

```python
import jax, jax.numpy as jnp
from jax import lax
import numpy as np

D_MODEL = 1024
BATCH = 8
SEQ = 2048
DEPTH = 1

GRID_W = 64
CTX_LEN = 256
N_MOD = 6
HG_HEADS = 4
HG_DK = 128
HG_DV = 128
GLA_HEADS = 4
GLA_DK = 128
GLA_DV = 128
GLA_RANK = 16
GLA_GATE_NORM = 16.0
HG_W = HG_HEADS * HG_DK
HG_VW = HG_HEADS * HG_DV
GLA_KW = GLA_HEADS * GLA_DK
GLA_VW = GLA_HEADS * GLA_DV
D_FF = ((8 * D_MODEL // 3 + 255) // 256) * 256
EPS = 1e-6
IN_SPLITS = (HG_W, HG_VW, HG_W, HG_W, HG_VW, GLA_KW, GLA_KW, GLA_VW, GLA_VW, GLA_RANK, GLA_RANK, D_MODEL, D_MODEL)
IN_WIDTH = sum(IN_SPLITS)
IN_OFFSETS = tuple(int(v) for v in np.cumsum(IN_SPLITS)[:-1])

kernel_name = "hybrid_hgrn2_gla_prefix_dit_block"


def rms_norm(a, w):
    af = a.astype(jnp.float32)
    return (af * lax.rsqrt(jnp.mean(af * af, axis=-1, keepdims=True) + EPS)).astype(a.dtype) * w


def modulate(h, shift_c, scale_c, shift_x, scale_x):
    hc, hx = h[:, :CTX_LEN], h[:, CTX_LEN:]
    return jnp.concatenate([hc * (1 + scale_c) + shift_c,
                            hx * (1 + scale_x[:, None]) + shift_x[:, None]], axis=1)


def apply_gate(h, gate_c, gate_x):
    return jnp.concatenate([h[:, :CTX_LEN] * gate_c, h[:, CTX_LEN:] * gate_x[:, None]], axis=1)


def to_heads(a, n_heads):
    b, t, w = a.shape
    return a.reshape(b, t, n_heads, w // n_heads).transpose(0, 2, 1, 3)


def merge_heads(a):
    b, h, t, d = a.shape
    return a.transpose(0, 2, 1, 3).reshape(b, t, h * d)


def segment_reverse(a):
    return jnp.concatenate([jnp.flip(a[:, :, :CTX_LEN], axis=2), jnp.flip(a[:, :, CTX_LEN:], axis=2)], axis=2)


def chunk_scan(q, k, v, log_f, n_chunks):
    b, h, t, dk = q.shape
    dv = v.shape[-1]

    def chunks(a):
        return jnp.moveaxis(a.reshape(b, h, n_chunks, GRID_W, a.shape[-1]), 2, 0)

    causal = jnp.tril(jnp.ones((GRID_W, GRID_W), dtype=bool))[:, :, None]

    def step(s, blk):
        qc, kc, vc, gc = blk
        cum = jnp.cumsum(gc.astype(jnp.float32), axis=2)
        pair = jnp.exp(jnp.where(causal, cum[:, :, :, None, :] - cum[:, :, None, :, :], -jnp.inf))
        scores = jnp.einsum('bhtk,bhtsk,bhsk->bhts', qc, pair, kc)
        o = (jnp.einsum('bhts,bhsv->bhtv', scores, vc)
             + jnp.einsum('bhtk,bhkv->bhtv', qc * jnp.exp(cum), s))
        tail = jnp.exp(cum[:, :, -1:, :] - cum)
        s_new = (s * jnp.exp(cum[:, :, -1, :])[..., None]
                 + jnp.einsum('bhsk,bhsv->bhkv', kc * tail, vc))
        return s_new, o

    s0 = jnp.zeros((b, h, dk, dv), jnp.float32)
    _, o = lax.scan(step, s0, (chunks(q), chunks(k), chunks(v), chunks(log_f)))
    return jnp.moveaxis(o, 0, 2).reshape(b, h, t, dv).astype(v.dtype)


def bidirectional_scan(q, k_fw, k_bw, v, lf_fw, lf_bw, n_chunks):
    o_fw = chunk_scan(q, k_fw, v, lf_fw, n_chunks)
    o_bw = chunk_scan(segment_reverse(q), segment_reverse(k_bw), segment_reverse(v),
                      segment_reverse(lf_bw), n_chunks)
    return o_fw + segment_reverse(o_bw)


def hybrid_mixer(h, w_in, lb, hg_onorm, gla_w_gk, gla_b_gk, gla_onorm, w_br_hg, w_br_gla, w_out, n_chunks):
    (hq, hi, hf_fw, hf_bw, hg_gate, gq, gk, gv, g_gate,
     lr_fw, lr_bw, gate_hg, gate_gla) = jnp.split(h @ w_in, IN_OFFSETS, axis=-1)

    def hg_forget(raw, lb_dir):
        f = lb_dir + (1 - lb_dir) * jax.nn.sigmoid(raw.astype(jnp.float32))
        return to_heads(1 - f, HG_HEADS), to_heads(jnp.log(f), HG_HEADS)

    q = to_heads(jax.nn.silu(hq), HG_HEADS)
    i = to_heads(hi, HG_HEADS)
    k_fw, lf_fw = hg_forget(hf_fw, lb[0])
    k_bw, lf_bw = hg_forget(hf_bw, lb[1])
    o = bidirectional_scan(q, k_fw, k_bw, i, lf_fw, lf_bw, n_chunks)
    o_hg = merge_heads(rms_norm(o, hg_onorm)) * jax.nn.silu(hg_gate)

    def gla_gate_log(lr, w, bias):
        return to_heads(jax.nn.log_sigmoid((lr @ w + bias).astype(jnp.float32)) / GLA_GATE_NORM, GLA_HEADS)

    q = to_heads(gq, GLA_HEADS) * GLA_DK ** -0.5
    k = to_heads(gk, GLA_HEADS)
    v = to_heads(gv, GLA_HEADS)
    lf_fw = gla_gate_log(lr_fw, gla_w_gk[0], gla_b_gk[0])
    lf_bw = gla_gate_log(lr_bw, gla_w_gk[1], gla_b_gk[1])
    o = bidirectional_scan(q, k, k, v, lf_fw, lf_bw, n_chunks)
    o_gla = merge_heads(rms_norm(o, gla_onorm)) * jax.nn.silu(g_gate)

    merged = (jax.nn.sigmoid(gate_hg) * (o_hg @ w_br_hg)
              + jax.nn.sigmoid(gate_gla) * (o_gla @ w_br_gla))
    return merged @ w_out


def swiglu(h, w_gate, w_up, w_down):
    return (jax.nn.silu(h @ w_gate) * (h @ w_up)) @ w_down


def setup_inputs(seed: int = 0) -> dict:
    key = jax.random.key(seed)
    ks = jax.random.split(key, 24)

    def nrm(k, shape, scale):
        return jax.random.normal(k, shape, jnp.float32) * scale

    def gain(k, shape):
        return 1.0 + nrm(k, shape, 0.05)

    return {
        "x": nrm(ks[0], (BATCH, SEQ, D_MODEL), 1.0),
        "c": nrm(ks[1], (BATCH, D_MODEL), 1.0),
        "ctx": nrm(ks[2], (BATCH, CTX_LEN, D_MODEL), 1.0),
        "c_ctx": nrm(ks[3], (D_MODEL,), 1.0),
        "w_mod": nrm(ks[4], (DEPTH, D_MODEL, N_MOD * D_MODEL), 0.5 * D_MODEL ** -0.5),
        "b_mod": nrm(ks[5], (DEPTH, N_MOD * D_MODEL), 0.01),
        "norm_pre1": gain(ks[6], (DEPTH, D_MODEL)),
        "norm_post1": gain(ks[7], (DEPTH, D_MODEL)),
        "norm_pre2": gain(ks[8], (DEPTH, D_MODEL)),
        "norm_post2": gain(ks[9], (DEPTH, D_MODEL)),
        "w_in": nrm(ks[10], (DEPTH, D_MODEL, IN_WIDTH), D_MODEL ** -0.5),
        "hg_lb": nrm(ks[11], (DEPTH + 1, 2, HG_W), 1.0),
        "hg_onorm": gain(ks[12], (DEPTH, HG_DV)),
        "gla_w_gk": nrm(ks[13], (DEPTH, 2, GLA_RANK, GLA_KW), GLA_RANK ** -0.5),
        "gla_b_gk": nrm(ks[14], (DEPTH, 2, GLA_KW), 0.1),
        "gla_onorm": gain(ks[15], (DEPTH, GLA_DV)),
        "w_br_hg": nrm(ks[16], (DEPTH, HG_VW, D_MODEL), HG_VW ** -0.5),
        "w_br_gla": nrm(ks[17], (DEPTH, GLA_VW, D_MODEL), GLA_VW ** -0.5),
        "w_out": nrm(ks[18], (DEPTH, D_MODEL, D_MODEL), D_MODEL ** -0.5),
        "w_ff_gate": nrm(ks[19], (DEPTH, D_MODEL, D_FF), D_MODEL ** -0.5),
        "w_ff_up": nrm(ks[20], (DEPTH, D_MODEL, D_FF), D_MODEL ** -0.5),
        "w_ff_down": nrm(ks[21], (DEPTH, D_FF, D_MODEL), D_FF ** -0.5),
    }


def reference(x, c, ctx, c_ctx, w_mod, b_mod, norm_pre1, norm_post1, norm_pre2, norm_post2, w_in, hg_lb,
              hg_onorm, gla_w_gk, gla_b_gk, gla_onorm, w_br_hg, w_br_gla, w_out, w_ff_gate, w_ff_up, w_ff_down):
    rows = x.shape[1] // GRID_W
    n_chunks = CTX_LEN // GRID_W + rows
    z = jnp.concatenate([ctx, x], axis=1)
    lb_all = jnp.cumsum(jax.nn.softmax(hg_lb.astype(jnp.float32), axis=0), axis=0)
    for l in range(DEPTH):
        m_c = jnp.split(jax.nn.silu(c_ctx) @ w_mod[l] + b_mod[l], N_MOD, axis=-1)
        m_x = jnp.split(jax.nn.silu(c) @ w_mod[l] + b_mod[l], N_MOD, axis=-1)
        h = modulate(rms_norm(z, norm_pre1[l]), m_c[0], m_c[1], m_x[0], m_x[1])
        y = hybrid_mixer(h, w_in[l], lb_all[l], hg_onorm[l], gla_w_gk[l], gla_b_gk[l], gla_onorm[l],
                         w_br_hg[l], w_br_gla[l], w_out[l], n_chunks)
        z = z + apply_gate(rms_norm(y, norm_post1[l]), m_c[2], m_x[2])
        h = modulate(rms_norm(z, norm_pre2[l]), m_c[3], m_c[4], m_x[3], m_x[4])
        y = swiglu(h, w_ff_gate[l], w_ff_up[l], w_ff_down[l])
        z = z + apply_gate(rms_norm(y, norm_post2[l]), m_c[5], m_x[5])
    return z[:, CTX_LEN:]
```

```cpp
#include <hip/hip_runtime.h>
#include <hip/hip_cooperative_groups.h>
#include <cstdio>
#include <cstdint>
namespace cg = cooperative_groups;

typedef unsigned short bf16;
typedef short bf16x8 __attribute__((ext_vector_type(8)));
typedef float f32x4 __attribute__((ext_vector_type(4)));
typedef unsigned u32x4 __attribute__((ext_vector_type(4)));
typedef unsigned u32x2 __attribute__((ext_vector_type(2)));
#define LAS __attribute__((address_space(3)))

constexpr int NB = 8, SEQ = 2048, CTXL = 256, D = 1024, DFF = 2816;
constexpr int MLAT = NB * SEQ, MCTX = NB * CTXL, MALL = MLAT + MCTX;
constexpr int INW = 6688, NMOD = 6144;
constexpr int NA = 3840;
constexpr int NBB = 3072;
constexpr int NGU = 2 * DFF;
constexpr float EPS = 1e-6f;
constexpr int NWAVES = 8, NTHREADS = 512;
constexpr int LDS_BYTES = 147456;

constexpr size_t MiB = 1u << 20;
constexpr size_t WS_CTL = 0;
constexpr size_t WS_MODV = 1 * MiB;
constexpr size_t WS_LB = WS_MODV + 512 * 1024;
constexpr size_t WS_WA = 2 * MiB;
constexpr size_t WS_WB = 10 * MiB;
constexpr size_t WS_WBRH = 16 * MiB;
constexpr size_t WS_WBRG = 17 * MiB;
constexpr size_t WS_WOUT = 18 * MiB;
constexpr size_t WS_WGU = 20 * MiB;
constexpr size_t WS_WD = 31 * MiB;
constexpr size_t WS_H1 = 37 * MiB;
constexpr size_t WS_PA = 73 * MiB;
constexpr size_t WS_A12 = 169 * MiB;
constexpr size_t WS_Y1 = 201 * MiB;
constexpr size_t WS_END = 233 * MiB;

struct Params {
    const float* in[22];
    float* out;
    unsigned char* ws;
    int ph_lo, ph_hi;
};

__device__ __forceinline__ unsigned f2bf(float f) { unsigned u = __builtin_bit_cast(unsigned, f); return (u + 0x7fffu + ((u >> 16) & 1u)) >> 16; }
__device__ __forceinline__ unsigned pk2(float lo, float hi) { return f2bf(lo) | (f2bf(hi) << 16); }
__device__ __forceinline__ float bf2f(unsigned b) { return __builtin_bit_cast(float, b << 16); }
__device__ __forceinline__ float bflo(unsigned w) { return __builtin_bit_cast(float, w << 16); }
__device__ __forceinline__ float bfhi(unsigned w) { return __builtin_bit_cast(float, w & 0xffff0000u); }
__device__ __forceinline__ float sigmoidf_(float x) { return 1.0f / (1.0f + __expf(-x)); }
__device__ __forceinline__ float siluf_(float x) { return x / (1.0f + __expf(-x)); }
__device__ __forceinline__ float wave_sum(float v) {
#pragma unroll
    for (int o = 1; o < 64; o <<= 1) v += __shfl_xor(v, o);
    return v;
}

__device__ __forceinline__ void transpose_item(const float* W, int ldw, int c0, int ncols, int Kdst, bf16* WT, int row0, int mode, LAS float* scr, int item, int lane) {
    const int nblk = ncols / 32, kb = item / nblk, nb = item % nblk, k0 = 64 * kb, n0 = 32 * nb;
#pragma unroll 8
    for (int i = 0; i < 32; ++i) { const int kk = 2 * i + (lane >> 5); scr[kk * 33 + (lane & 31)] = W[(size_t)(k0 + kk) * ldw + c0 + n0 + (lane & 31)]; }
    asm volatile("s_waitcnt lgkmcnt(0)" ::: "memory");
    const int c = lane & 7;
#pragma unroll
    for (int j = 0; j < 4; ++j) {
        const int n = (lane >> 3) + 8 * j; const LAS float* s = scr + (8 * c) * 33 + n;
        u32x4 o; o.x = pk2(s[0 * 33], s[1 * 33]); o.y = pk2(s[2 * 33], s[3 * 33]); o.z = pk2(s[4 * 33], s[5 * 33]); o.w = pk2(s[6 * 33], s[7 * 33]);
        const int nn = n0 + n;
        const int drow = mode == 0 ? row0 + nn : (2 * (nn & ~15) + (nn & 15) + (mode == 2 ? 16 : 0));
        *(u32x4*)(WT + (size_t)drow * Kdst + k0 + 8 * c) = o;
    }
    asm volatile("s_waitcnt lgkmcnt(0)" ::: "memory");
}

__device__ __forceinline__ void phase0(const Params& p, LAS unsigned char* lds) {
    const int tid = threadIdx.x, lane = tid & 63, wave = tid >> 6;
    unsigned char* ws = p.ws;
    {
        LAS float* sil = (LAS float*)lds;
        LAS float* red = (LAS float*)(lds + 49152);
        const float* cv = p.in[1]; const float* cc = p.in[3]; const float* wm = p.in[4]; const float* bm = p.in[5];
        float* modv = (float*)(ws + WS_MODV);
        for (int it = blockIdx.x; it < NMOD / 64; it += gridDim.x) {
            __syncthreads();
            for (int e = tid; e < 9 * 1024; e += NTHREADS) { const int r = e >> 10, k = e & 1023; const float v = r < 8 ? cv[r * 1024 + k] : cc[k]; sil[k * 12 + r] = siluf_(v); }
            __syncthreads();
            const int j = it * 64 + lane;
            float acc[9];
#pragma unroll
            for (int r = 0; r < 9; ++r) acc[r] = 0.f;
            const int kbeg = wave * 128;
#pragma unroll 4
            for (int k = kbeg; k < kbeg + 128; ++k) {
                const float w = wm[(size_t)k * NMOD + j];
                const f32x4 s0 = *(const LAS f32x4*)(sil + k * 12), s1 = *(const LAS f32x4*)(sil + k * 12 + 4); const float s8 = sil[k * 12 + 8];
                acc[0] += s0[0] * w; acc[1] += s0[1] * w; acc[2] += s0[2] * w; acc[3] += s0[3] * w;
                acc[4] += s1[0] * w; acc[5] += s1[1] * w; acc[6] += s1[2] * w; acc[7] += s1[3] * w; acc[8] += s8 * w;
            }
#pragma unroll
            for (int r = 0; r < 9; ++r) red[(wave * 9 + r) * 64 + lane] = acc[r];
            __syncthreads();
            for (int e = tid; e < 9 * 64; e += NTHREADS) {
                const int r = e >> 6, l = e & 63; float s = 0.f;
#pragma unroll
                for (int w2 = 0; w2 < 8; ++w2) s += red[(w2 * 9 + r) * 64 + l];
                modv[(size_t)r * NMOD + it * 64 + l] = s + bm[it * 64 + l];
            }
        }
        __syncthreads();
    }
    {
        const int gt = blockIdx.x * NTHREADS + tid, GT = gridDim.x * NTHREADS;
        const float* hl = p.in[11]; float* lb = (float*)(ws + WS_LB);
        for (int e = gt; e < 1024; e += GT) lb[e] = sigmoidf_(hl[e] - hl[1024 + e]);
        u32x4* padp = (u32x4*)(ws + WS_WA + (size_t)3616 * 1024 * 2); const u32x4 z = {0u, 0u, 0u, 0u};
        for (int e = gt; e < 224 * 1024 * 2 / 16; e += GT) padp[e] = z;
    }
    {
        LAS float* scr = (LAS float*)(lds + wave * 8448);
        const int gw = blockIdx.x * NWAVES + wave, NGW = gridDim.x * NWAVES;
        const float* w_in = p.in[10];
        bf16* WA = (bf16*)(ws + WS_WA); bf16* WB = (bf16*)(ws + WS_WB);
        constexpr int I1 = 16 * 64, I2 = 16 * 48, I3 = 16 * 1, I4 = 16 * 16, I5 = 16 * 16, I6 = 16 * 64, I7 = 8 * 32, I8 = 8 * 32, I9 = 16 * 32, I10 = 16 * 88, I11 = 16 * 88, I12 = 44 * 32;
        constexpr int NIT = I1 + I2 + I3 + I4 + I5 + I6 + I7 + I8 + I9 + I10 + I11 + I12;
        for (int it = gw; it < NIT; it += NGW) {
            int r = it;
            if (r < I1) { transpose_item(w_in, INW, 0, 2048, 1024, WA, 0, 0, scr, r, lane); continue; } r -= I1;
            if (r < I2) { transpose_item(w_in, INW, 2560, 1536, 1024, WA, 2048, 0, scr, r, lane); continue; } r -= I2;
            if (r < I3) { transpose_item(w_in, INW, 4608, 32, 1024, WA, 3584, 0, scr, r, lane); continue; } r -= I3;
            if (r < I4) { transpose_item(w_in, INW, 2048, 512, 1024, WB, 0, 0, scr, r, lane); continue; } r -= I4;
            if (r < I5) { transpose_item(w_in, INW, 4096, 512, 1024, WB, 512, 0, scr, r, lane); continue; } r -= I5;
            if (r < I6) { transpose_item(w_in, INW, 4640, 2048, 1024, WB, 1024, 0, scr, r, lane); continue; } r -= I6;
            if (r < I7) { transpose_item(p.in[16], 1024, 0, 1024, 512, (bf16*)(ws + WS_WBRH), 0, 0, scr, r, lane); continue; } r -= I7;
            if (r < I8) { transpose_item(p.in[17], 1024, 0, 1024, 512, (bf16*)(ws + WS_WBRG), 0, 0, scr, r, lane); continue; } r -= I8;
            if (r < I9) { transpose_item(p.in[18], 1024, 0, 1024, 1024, (bf16*)(ws + WS_WOUT), 0, 0, scr, r, lane); continue; } r -= I9;
            if (r < I10) { transpose_item(p.in[19], DFF, 0, DFF, 1024, (bf16*)(ws + WS_WGU), 0, 1, scr, r, lane); continue; } r -= I10;
            if (r < I11) { transpose_item(p.in[20], DFF, 0, DFF, 1024, (bf16*)(ws + WS_WGU), 0, 2, scr, r, lane); continue; } r -= I11;
            transpose_item(p.in[21], 1024, 0, 1024, DFF, (bf16*)(ws + WS_WD), 0, 0, scr, r, lane);
        }
    }
}

__device__ __forceinline__ void phase1(const Params& p) {
    const int tid = threadIdx.x, lane = tid & 63, wave = tid >> 6;
    const int gw = blockIdx.x * NWAVES + wave, NGW = gridDim.x * NWAVES;
    const float* x = p.in[0]; const float* ctx = p.in[2]; const float* pre1 = p.in[6];
    const float* modv = (const float*)(p.ws + WS_MODV); bf16* h1 = (bf16*)(p.ws + WS_H1);
    for (int m = gw; m < MALL; m += NGW) {
        const float* src = m < MLAT ? x + (size_t)m * D : ctx + (size_t)(m - MLAT) * D;
        const float* mv = modv + (size_t)(m < MLAT ? m / SEQ : 8) * NMOD;
        f32x4 v[4]; float ss = 0.f;
#pragma unroll
        for (int j = 0; j < 4; ++j) { v[j] = ((const f32x4*)src)[lane + 64 * j]; ss += (v[j][0] * v[j][0] + v[j][1] * v[j][1]) + (v[j][2] * v[j][2] + v[j][3] * v[j][3]); }
        const float rstd = 1.0f / sqrtf(wave_sum(ss) * (1.0f / D) + EPS);
#pragma unroll
        for (int j = 0; j < 4; ++j) {
            const int col = 4 * lane + 256 * j;
            const f32x4 w = *(const f32x4*)(pre1 + col), sh = *(const f32x4*)(mv + col), sc = *(const f32x4*)(mv + 1024 + col);
            f32x4 h;
#pragma unroll
            for (int e = 0; e < 4; ++e) h[e] = v[j][e] * rstd * w[e] * (1.0f + sc[e]) + sh[e];
            u32x2 o; o.x = pk2(h[0], h[1]); o.y = pk2(h[2], h[3]);
            *(u32x2*)(h1 + (size_t)m * D + col) = o;
        }
    }
}

template <class Epi>
__device__ __forceinline__ void gemm_simple(const bf16* A, int lda, const bf16* Bt, int ldb, int M, int N, int K, const Epi& epi) {
    const int tid = threadIdx.x, lane = tid & 63, wave = tid >> 6, wm = wave >> 1, wn = wave & 1;
    const int ntn = N / 128, ntiles = (M / 128) * ntn;
    for (int tile = blockIdx.x; tile < ntiles; tile += gridDim.x) {
        const int tm = tile / ntn, tn = tile % ntn;
        const int row0 = tm * 128 + wm * 32, col0 = tn * 128 + wn * 64;
        f32x4 acc[2][4];
#pragma unroll
        for (int i = 0; i < 2; ++i)
#pragma unroll
            for (int j = 0; j < 4; ++j) acc[i][j] = (f32x4){0.f, 0.f, 0.f, 0.f};
        const bf16* ap = A + (size_t)(row0 + (lane & 15)) * lda + 8 * (lane >> 4);
        const bf16* bp = Bt + (size_t)(col0 + (lane & 15)) * ldb + 8 * (lane >> 4);
#pragma unroll 2
        for (int k0 = 0; k0 < K; k0 += 32) {
            bf16x8 a[2], b[4];
#pragma unroll
            for (int i = 0; i < 2; ++i) a[i] = *(const bf16x8*)(ap + (size_t)i * 16 * lda + k0);
#pragma unroll
            for (int j = 0; j < 4; ++j) b[j] = *(const bf16x8*)(bp + (size_t)j * 16 * ldb + k0);
#pragma unroll
            for (int i = 0; i < 2; ++i)
#pragma unroll
                for (int j = 0; j < 4; ++j) acc[i][j] = __builtin_amdgcn_mfma_f32_16x16x32_bf16(a[i], b[j], acc[i][j], 0, 0, 0);
        }
        epi(acc, row0, col0, lane);
    }
}

struct EpiStore {
    bf16* C; int ldc;
    __device__ __forceinline__ void operator()(const f32x4 (&acc)[2][4], int row0, int col0, int lane) const {
#pragma unroll
        for (int i = 0; i < 2; ++i)
#pragma unroll
            for (int j = 0; j < 4; ++j)
#pragma unroll
                for (int r = 0; r < 4; ++r) C[(size_t)(row0 + 16 * i + 4 * (lane >> 4) + r) * ldc + col0 + 16 * j + (lane & 15)] = (bf16)f2bf(acc[i][j][r]);
    }
};
struct EpiBr {
    bf16* T; const bf16* PB; int gcol0; int second;
    __device__ __forceinline__ void operator()(const f32x4 (&acc)[2][4], int row0, int col0, int lane) const {
#pragma unroll
        for (int i = 0; i < 2; ++i)
#pragma unroll
            for (int j = 0; j < 4; ++j)
#pragma unroll
                for (int r = 0; r < 4; ++r) {
                    const int row = row0 + 16 * i + 4 * (lane >> 4) + r, col = col0 + 16 * j + (lane & 15);
                    const float g = sigmoidf_(bf2f(PB[(size_t)row * NBB + gcol0 + col]));
                    float v = g * acc[i][j][r];
                    if (second) v += bf2f(T[(size_t)row * D + col]);
                    T[(size_t)row * D + col] = (bf16)f2bf(v);
                }
    }
};
struct EpiGU {
    bf16* ACT;
    __device__ __forceinline__ void operator()(const f32x4 (&acc)[2][4], int row0, int col0, int lane) const {
#pragma unroll
        for (int i = 0; i < 2; ++i)
#pragma unroll
            for (int jj = 0; jj < 2; ++jj)
#pragma unroll
                for (int r = 0; r < 4; ++r) {
                    const int row = row0 + 16 * i + 4 * (lane >> 4) + r, ch = ((col0 + 32 * jj) >> 5) * 16 + (lane & 15);
                    ACT[(size_t)row * DFF + ch] = (bf16)f2bf(siluf_(acc[i][2 * jj][r]) * acc[i][2 * jj + 1][r]);
                }
    }
};

__device__ __forceinline__ void phase3(const Params& p, LAS unsigned char* lds) {
    const int tid = threadIdx.x;
    const bf16* PA = (const bf16*)(p.ws + WS_PA);
    const float* lbv = (const float*)(p.ws + WS_LB);
    bf16* O = (bf16*)p.out;
    LAS float* sq = (LAS float*)lds;
    LAS float* sf = sq + 2048;
    LAS float* sk = sf + 2048;
    LAS float* sv = sk + 2048;
    LAS float* red = sv + 2048;
    const int c = tid & 127, kg = tid >> 7;
    const int lj = tid >> 5, k4 = (tid & 31) * 4;
    for (int it = blockIdx.x; it < 128; it += gridDim.x) {
        const int b = it & 7, hh = (it >> 3) & 3, dir = (it >> 5) & 1, br = it >> 6;
        float S[32];
#pragma unroll
        for (int k = 0; k < 32; ++k) S[k] = 0.f;
        const int qcol = (br ? 2048 : 0) + hh * 128;
        const int fcol = br ? 2560 + hh * 128 : 1024 + dir * 512 + hh * 128;
        const int vcol = (br ? 3072 : 512) + hh * 128;
        const int lrcol = 3584 + dir * 16;
        f32x4 lb4 = {0.f, 0.f, 0.f, 0.f}, bg4 = {0.f, 0.f, 0.f, 0.f};
        if (br == 0) lb4 = *(const f32x4*)(lbv + dir * 512 + hh * 128 + k4);
        else bg4 = *(const f32x4*)(p.in[14] + dir * 512 + hh * 128 + k4);
#pragma unroll 1
        for (int step = 0; step < (CTXL + SEQ) / 16; ++step) {
            __syncthreads();
            {
                const int pos = step * 16 + lj;
                int row;
                if (pos < CTXL) row = MLAT + b * CTXL + (dir ? CTXL - 1 - pos : pos);
                else { const int t = pos - CTXL; row = b * SEQ + (dir ? SEQ - 1 - t : t); }
                const bf16* pr = PA + (size_t)row * NA;
                const u32x2 q2 = *(const u32x2*)(pr + qcol + k4), f2 = *(const u32x2*)(pr + fcol + k4), v2 = *(const u32x2*)(pr + vcol + k4);
                f32x4 qv = {bflo(q2.x), bfhi(q2.x), bflo(q2.y), bfhi(q2.y)};
                f32x4 fv = {bflo(f2.x), bfhi(f2.x), bflo(f2.y), bfhi(f2.y)};
                const f32x4 vv = {bflo(v2.x), bfhi(v2.x), bflo(v2.y), bfhi(v2.y)};
                f32x4 kv;
                if (br == 0) {
#pragma unroll
                    for (int e = 0; e < 4; ++e) { const float f = lb4[e] + (1.0f - lb4[e]) * sigmoidf_(fv[e]); kv[e] = 1.0f - f; fv[e] = f; qv[e] = siluf_(qv[e]); }
                } else {
                    const u32x4 l0 = *(const u32x4*)(pr + lrcol), l1 = *(const u32x4*)(pr + lrcol + 8);
                    const float lr[16] = {bflo(l0.x), bfhi(l0.x), bflo(l0.y), bfhi(l0.y), bflo(l0.z), bfhi(l0.z), bflo(l0.w), bfhi(l0.w),
                                          bflo(l1.x), bfhi(l1.x), bflo(l1.y), bfhi(l1.y), bflo(l1.z), bfhi(l1.z), bflo(l1.w), bfhi(l1.w)};
                    f32x4 xg = bg4;
                    const float* wgp = p.in[13] + (size_t)(dir * 16) * 512 + hh * 128 + k4;
                    asm volatile("" : "+v"(wgp));
#pragma unroll
                    for (int r = 0; r < 16; ++r) xg += lr[r] * *(const f32x4*)(wgp + r * 512);
                    kv = fv;
#pragma unroll
                    for (int e = 0; e < 4; ++e) {
                        const float ls = fminf(xg[e], 0.f) - log1pf(__expf(-fabsf(xg[e])));
                        fv[e] = __expf(ls * (1.0f / 16.0f)); qv[e] *= 0.08838834764831845f;
                    }
                }
                *(LAS f32x4*)(sq + lj * 128 + k4) = qv; *(LAS f32x4*)(sf + lj * 128 + k4) = fv; *(LAS f32x4*)(sk + lj * 128 + k4) = kv; *(LAS f32x4*)(sv + lj * 128 + k4) = vv;
            }
            __syncthreads();
#pragma unroll 1
            for (int j = 0; j < 16; ++j) {
                const float vc = sv[j * 128 + c];
                float acc = 0.f;
#pragma unroll
                for (int k = 0; k < 32; k += 4) {
                    const f32x4 f4 = *(const LAS f32x4*)(sf + j * 128 + kg * 32 + k), k4v = *(const LAS f32x4*)(sk + j * 128 + kg * 32 + k), q4 = *(const LAS f32x4*)(sq + j * 128 + kg * 32 + k);
#pragma unroll
                    for (int e = 0; e < 4; ++e) { S[k + e] = f4[e] * S[k + e] + k4v[e] * vc; acc += q4[e] * S[k + e]; }
                }
                red[(kg * 16 + j) * 128 + c] = acc;
            }
            __syncthreads();
            if (step * 16 >= CTXL) {
                const int t = step * 16 + lj - CTXL;
                const int row = b * SEQ + (dir ? SEQ - 1 - t : t);
                f32x4 o = *(const LAS f32x4*)(red + (0 * 16 + lj) * 128 + k4);
                o += *(const LAS f32x4*)(red + (1 * 16 + lj) * 128 + k4);
                o += *(const LAS f32x4*)(red + (2 * 16 + lj) * 128 + k4);
                o += *(const LAS f32x4*)(red + (3 * 16 + lj) * 128 + k4);
                u32x2 w; w.x = pk2(o[0], o[1]); w.y = pk2(o[2], o[3]);
                *(u32x2*)(O + ((size_t)(br * 2 + dir) * MLAT + row) * 512 + hh * 128 + k4) = w;
            }
        }
        __syncthreads();
    }
}

__device__ __forceinline__ void phase5(const Params& p) {
    const int tid = threadIdx.x, lane = tid & 63, wave = tid >> 6;
    const int gw = blockIdx.x * NWAVES + wave, NGW = gridDim.x * NWAVES;
    const bf16* O = (const bf16*)p.out; const bf16* PB = (const bf16*)(p.ws + WS_PA); bf16* A12 = (bf16*)(p.ws + WS_A12);
    for (int m = gw; m < MLAT; m += NGW) {
#pragma unroll
        for (int hd = 0; hd < 8; ++hd) {
            const int br = hd >> 2, col = (hd & 3) * 128 + 2 * lane;
            const unsigned a = *(const unsigned*)(O + ((size_t)(br * 2 + 0) * MLAT + m) * 512 + col), bq = *(const unsigned*)(O + ((size_t)(br * 2 + 1) * MLAT + m) * 512 + col);
            const float o0 = bflo(a) + bflo(bq), o1 = bfhi(a) + bfhi(bq);
            const float rstd = 1.0f / sqrtf(wave_sum(o0 * o0 + o1 * o1) * (1.0f / 128.0f) + EPS);
            const unsigned g = *(const unsigned*)(PB + (size_t)m * NBB + br * 512 + col);
            const float* on = (br ? p.in[15] : p.in[12]) + 2 * lane;
            const float r0 = o0 * rstd * on[0] * siluf_(bflo(g)), r1 = o1 * rstd * on[1] * siluf_(bfhi(g));
            *(unsigned*)(A12 + (size_t)m * D + hd * 128 + 2 * lane) = pk2(r0, r1);
        }
    }
}

__device__ __forceinline__ void phase8(const Params& p) {
    const int tid = threadIdx.x, lane = tid & 63, wave = tid >> 6;
    const int gw = blockIdx.x * NWAVES + wave, NGW = gridDim.x * NWAVES;
    const float* x = p.in[0]; const float* post1 = p.in[7]; const float* pre2 = p.in[8];
    const float* modv = (const float*)(p.ws + WS_MODV); const bf16* y1 = (const bf16*)(p.ws + WS_Y1); bf16* h2 = (bf16*)(p.ws + WS_H1);
    for (int m = gw; m < MLAT; m += NGW) {
        const float* mv = modv + (size_t)(m / SEQ) * NMOD;
        f32x4 y[4], z[4]; float ss = 0.f;
#pragma unroll
        for (int j = 0; j < 4; ++j) {
            const u32x2 w = *(const u32x2*)(y1 + (size_t)m * D + 4 * lane + 256 * j);
            y[j] = (f32x4){bflo(w.x), bfhi(w.x), bflo(w.y), bfhi(w.y)};
            ss += (y[j][0] * y[j][0] + y[j][1] * y[j][1]) + (y[j][2] * y[j][2] + y[j][3] * y[j][3]);
        }
        const float rstd1 = 1.0f / sqrtf(wave_sum(ss) * (1.0f / D) + EPS);
        float s2 = 0.f;
#pragma unroll
        for (int j = 0; j < 4; ++j) {
            const int col = 4 * lane + 256 * j;
            const f32x4 xv = *(const f32x4*)(x + (size_t)m * D + col), w = *(const f32x4*)(post1 + col), g = *(const f32x4*)(mv + 2048 + col);
#pragma unroll
            for (int e = 0; e < 4; ++e) { z[j][e] = xv[e] + g[e] * (y[j][e] * rstd1 * w[e]); s2 += z[j][e] * z[j][e]; }
            *(f32x4*)(p.out + (size_t)m * D + col) = z[j];
        }
        const float rstdz = 1.0f / sqrtf(wave_sum(s2) * (1.0f / D) + EPS);
#pragma unroll
        for (int j = 0; j < 4; ++j) {
            const int col = 4 * lane + 256 * j;
            const f32x4 w = *(const f32x4*)(pre2 + col), sh = *(const f32x4*)(mv + 3072 + col), sc = *(const f32x4*)(mv + 4096 + col);
            f32x4 h;
#pragma unroll
            for (int e = 0; e < 4; ++e) h[e] = z[j][e] * rstdz * w[e] * (1.0f + sc[e]) + sh[e];
            u32x2 o; o.x = pk2(h[0], h[1]); o.y = pk2(h[2], h[3]);
            *(u32x2*)(h2 + (size_t)m * D + col) = o;
        }
    }
}

__device__ __forceinline__ void phase11(const Params& p) {
    const int tid = threadIdx.x, lane = tid & 63, wave = tid >> 6;
    const int gw = blockIdx.x * NWAVES + wave, NGW = gridDim.x * NWAVES;
    const float* post2 = p.in[9];
    const float* modv = (const float*)(p.ws + WS_MODV); const bf16* y2 = (const bf16*)(p.ws + WS_A12);
    for (int m = gw; m < MLAT; m += NGW) {
        const float* mv = modv + (size_t)(m / SEQ) * NMOD;
        f32x4 y[4]; float ss = 0.f;
#pragma unroll
        for (int j = 0; j < 4; ++j) {
            const u32x2 w = *(const u32x2*)(y2 + (size_t)m * D + 4 * lane + 256 * j);
            y[j] = (f32x4){bflo(w.x), bfhi(w.x), bflo(w.y), bfhi(w.y)};
            ss += (y[j][0] * y[j][0] + y[j][1] * y[j][1]) + (y[j][2] * y[j][2] + y[j][3] * y[j][3]);
        }
        const float rstd2 = 1.0f / sqrtf(wave_sum(ss) * (1.0f / D) + EPS);
#pragma unroll
        for (int j = 0; j < 4; ++j) {
            const int col = 4 * lane + 256 * j;
            const f32x4 w = *(const f32x4*)(post2 + col), g = *(const f32x4*)(mv + 5120 + col);
            f32x4 z = *(const f32x4*)(p.out + (size_t)m * D + col);
#pragma unroll
            for (int e = 0; e < 4; ++e) z[e] += g[e] * (y[j][e] * rstd2 * w[e]);
            *(f32x4*)(p.out + (size_t)m * D + col) = z;
        }
    }
}

__global__ void __launch_bounds__(NTHREADS, 2) fwd_kernel(Params p) {
    extern __shared__ __attribute__((aligned(16))) unsigned char lds_raw[];
    LAS unsigned char* lds = (LAS unsigned char*)lds_raw;
    cg::grid_group grid = cg::this_grid();
    unsigned char* ws = p.ws;
    const int lo = p.ph_lo, hi = p.ph_hi;
#define IN(k) (lo <= (k) && (k) < hi)
#define SYNC(k) do { if (IN(k) && IN((k) + 1)) grid.sync(); } while (0)
    if (IN(0)) phase0(p, lds);
    SYNC(0);
    if (IN(1)) phase1(p);
    SYNC(1);
    if (IN(2)) { EpiStore e{(bf16*)(ws + WS_PA), NA}; gemm_simple((const bf16*)(ws + WS_H1), D, (const bf16*)(ws + WS_WA), D, MALL, NA, D, e); }
    SYNC(2);
    if (IN(3)) phase3(p, lds);
    SYNC(3);
    if (IN(4)) { EpiStore e{(bf16*)(ws + WS_PA), NBB}; gemm_simple((const bf16*)(ws + WS_H1), D, (const bf16*)(ws + WS_WB), D, MLAT, NBB, D, e); }
    SYNC(4);
    if (IN(5)) phase5(p);
    SYNC(5);
    if (IN(6)) {
        EpiBr e1{(bf16*)(ws + WS_H1), (const bf16*)(ws + WS_PA), 1024, 0};
        gemm_simple((const bf16*)(ws + WS_A12), D, (const bf16*)(ws + WS_WBRH), 512, MLAT, D, 512, e1);
        EpiBr e2{(bf16*)(ws + WS_H1), (const bf16*)(ws + WS_PA), 2048, 1};
        gemm_simple((const bf16*)(ws + WS_A12) + 512, D, (const bf16*)(ws + WS_WBRG), 512, MLAT, D, 512, e2);
    }
    SYNC(6);
    if (IN(7)) { EpiStore e{(bf16*)(ws + WS_Y1), D}; gemm_simple((const bf16*)(ws + WS_H1), D, (const bf16*)(ws + WS_WOUT), D, MLAT, D, D, e); }
    SYNC(7);
    if (IN(8)) phase8(p);
    SYNC(8);
    if (IN(9)) { EpiGU e{(bf16*)(ws + WS_PA)}; gemm_simple((const bf16*)(ws + WS_H1), D, (const bf16*)(ws + WS_WGU), D, MLAT, NGU, D, e); }
    SYNC(9);
    if (IN(10)) { EpiStore e{(bf16*)(ws + WS_A12), D}; gemm_simple((const bf16*)(ws + WS_PA), DFF, (const bf16*)(ws + WS_WD), DFF, MLAT, D, DFF, e); }
    SYNC(10);
    if (IN(11)) phase11(p);
#undef IN
#undef SYNC
}

extern "C" void kernel_launch(void* const* d_in, const int* in_sizes, int n_in, void* d_out, int out_size, void* d_ws, size_t ws_size, hipStream_t stream) {
    static int grid = 0;
    if (grid == 0) {
        if (n_in != 22 || out_size != MLAT * D || ws_size < WS_END) { fprintf(stderr, "kernel_launch: unexpected shapes (n_in %d out %d ws %zu)\n", n_in, out_size, ws_size); grid = -1; return; }
        int dev = 0, cus = 0, per_cu = 0;
        hipGetDevice(&dev);
        hipDeviceGetAttribute(&cus, hipDeviceAttributeMultiprocessorCount, dev);
        hipFuncSetAttribute((const void*)fwd_kernel, hipFuncAttributeMaxDynamicSharedMemorySize, LDS_BYTES);
        hipOccupancyMaxActiveBlocksPerMultiprocessor(&per_cu, (const void*)fwd_kernel, NTHREADS, LDS_BYTES);
        if (per_cu < 1) { fprintf(stderr, "kernel_launch: occupancy query says %d blocks/CU\n", per_cu); per_cu = 1; }
        grid = cus * 1;
        (void)hipGetLastError();
    }
    if (grid < 0) return;
    Params p{};
    for (int i = 0; i < 22; ++i) p.in[i] = (const float*)d_in[i];
    p.out = (float*)d_out; p.ws = (unsigned char*)d_ws; p.ph_lo = 0; p.ph_hi = 12;
    void* args[] = {&p};
    hipError_t e = hipLaunchCooperativeKernel((const void*)fwd_kernel, dim3(grid), dim3(NTHREADS), args, LDS_BYTES, stream);
    if (e != hipSuccess) fprintf(stderr, "cooperative launch failed: %s (grid %d)\n", hipGetErrorString(e), grid);
}
```

```cpp
#include <hip/hip_runtime.h>
#include <hip/hip_cooperative_groups.h>
#include <cstdio>
#include <cstdint>
namespace cg = cooperative_groups;

typedef unsigned short bf16;
typedef short bf16x8 __attribute__((ext_vector_type(8)));
typedef float f32x4 __attribute__((ext_vector_type(4)));
typedef unsigned u32x4 __attribute__((ext_vector_type(4)));
typedef unsigned u32x2 __attribute__((ext_vector_type(2)));
#define LAS __attribute__((address_space(3)))

constexpr int NB = 8, SEQ = 2048, CTXL = 256, D = 1024, DFF = 2816;
constexpr int MLAT = NB * SEQ, MCTX = NB * CTXL, MALL = MLAT + MCTX;
constexpr int INW = 6688, NMOD = 6144;
constexpr int NA = 3840;
constexpr int NBB = 3072;
constexpr int NGU = 2 * DFF;
constexpr float EPS = 1e-6f;
constexpr int NWAVES = 8, NTHREADS = 512;
constexpr int LDS_BYTES = 147456;

constexpr size_t MiB = 1u << 20;
constexpr size_t WS_CTL = 0;
constexpr size_t WS_MODV = 1 * MiB;
constexpr size_t WS_LB = WS_MODV + 512 * 1024;
constexpr size_t WS_WA = 2 * MiB;
constexpr size_t WS_WB = 10 * MiB;
constexpr size_t WS_WBRH = 16 * MiB;
constexpr size_t WS_WBRG = 17 * MiB;
constexpr size_t WS_WOUT = 18 * MiB;
constexpr size_t WS_WGU = 20 * MiB;
constexpr size_t WS_WD = 31 * MiB;
constexpr size_t WS_H1 = 37 * MiB;
constexpr size_t WS_PA = 73 * MiB;
constexpr size_t WS_A12 = 169 * MiB;
constexpr size_t WS_Y1 = 201 * MiB;
constexpr size_t WS_END = 233 * MiB;

struct Params {
    const float* in[22];
    float* out;
    unsigned char* ws;
    int ph_lo, ph_hi;
};

__device__ __forceinline__ unsigned f2bf(float f) { unsigned u = __builtin_bit_cast(unsigned, f); return (u + 0x7fffu + ((u >> 16) & 1u)) >> 16; }
__device__ __forceinline__ unsigned pk2(float lo, float hi) { return f2bf(lo) | (f2bf(hi) << 16); }
__device__ __forceinline__ float bf2f(unsigned b) { return __builtin_bit_cast(float, b << 16); }
__device__ __forceinline__ float bflo(unsigned w) { return __builtin_bit_cast(float, w << 16); }
__device__ __forceinline__ float bfhi(unsigned w) { return __builtin_bit_cast(float, w & 0xffff0000u); }
__device__ __forceinline__ float sigmoidf_(float x) { return 1.0f / (1.0f + __expf(-x)); }
__device__ __forceinline__ float siluf_(float x) { return x / (1.0f + __expf(-x)); }
__device__ __forceinline__ float wave_sum(float v) {
#pragma unroll
    for (int o = 1; o < 64; o <<= 1) v += __shfl_xor(v, o);
    return v;
}

__device__ __forceinline__ void transpose_item(const float* W, int ldw, int c0, int ncols, int Kdst, bf16* WT, int row0, int mode, LAS float* scr, int item, int lane) {
    const int nblk = ncols / 32, kb = item / nblk, nb = item % nblk, k0 = 64 * kb, n0 = 32 * nb;
#pragma unroll 8
    for (int i = 0; i < 32; ++i) { const int kk = 2 * i + (lane >> 5); scr[kk * 33 + (lane & 31)] = W[(size_t)(k0 + kk) * ldw + c0 + n0 + (lane & 31)]; }
    asm volatile("s_waitcnt lgkmcnt(0)" ::: "memory");
    const int c = lane & 7;
#pragma unroll
    for (int j = 0; j < 4; ++j) {
        const int n = (lane >> 3) + 8 * j; const LAS float* s = scr + (8 * c) * 33 + n;
        u32x4 o; o.x = pk2(s[0 * 33], s[1 * 33]); o.y = pk2(s[2 * 33], s[3 * 33]); o.z = pk2(s[4 * 33], s[5 * 33]); o.w = pk2(s[6 * 33], s[7 * 33]);
        const int nn = n0 + n;
        const int drow = mode == 0 ? row0 + nn : (2 * (nn & ~15) + (nn & 15) + (mode == 2 ? 16 : 0));
        *(u32x4*)(WT + (size_t)drow * Kdst + k0 + 8 * c) = o;
    }
    asm volatile("s_waitcnt lgkmcnt(0)" ::: "memory");
}

__device__ __forceinline__ void phase0(const Params& p, LAS unsigned char* lds) {
    const int tid = threadIdx.x, lane = tid & 63, wave = tid >> 6;
    unsigned char* ws = p.ws;
    {
        LAS float* sil = (LAS float*)lds;
        LAS float* red = (LAS float*)(lds + 49152);
        const float* cv = p.in[1]; const float* cc = p.in[3]; const float* wm = p.in[4]; const float* bm = p.in[5];
        float* modv = (float*)(ws + WS_MODV);
        for (int it = blockIdx.x; it < NMOD / 64; it += gridDim.x) {
            __syncthreads();
            for (int e = tid; e < 9 * 1024; e += NTHREADS) { const int r = e >> 10, k = e & 1023; const float v = r < 8 ? cv[r * 1024 + k] : cc[k]; sil[k * 12 + r] = siluf_(v); }
            __syncthreads();
            const int j = it * 64 + lane;
            float acc[9];
#pragma unroll
            for (int r = 0; r < 9; ++r) acc[r] = 0.f;
            const int kbeg = wave * 128;
#pragma unroll 4
            for (int k = kbeg; k < kbeg + 128; ++k) {
                const float w = wm[(size_t)k * NMOD + j];
                const f32x4 s0 = *(const LAS f32x4*)(sil + k * 12), s1 = *(const LAS f32x4*)(sil + k * 12 + 4); const float s8 = sil[k * 12 + 8];
                acc[0] += s0[0] * w; acc[1] += s0[1] * w; acc[2] += s0[2] * w; acc[3] += s0[3] * w;
                acc[4] += s1[0] * w; acc[5] += s1[1] * w; acc[6] += s1[2] * w; acc[7] += s1[3] * w; acc[8] += s8 * w;
            }
#pragma unroll
            for (int r = 0; r < 9; ++r) red[(wave * 9 + r) * 64 + lane] = acc[r];
            __syncthreads();
            for (int e = tid; e < 9 * 64; e += NTHREADS) {
                const int r = e >> 6, l = e & 63; float s = 0.f;
#pragma unroll
                for (int w2 = 0; w2 < 8; ++w2) s += red[(w2 * 9 + r) * 64 + l];
                modv[(size_t)r * NMOD + it * 64 + l] = s + bm[it * 64 + l];
            }
        }
        __syncthreads();
    }
    {
        const int gt = blockIdx.x * NTHREADS + tid, GT = gridDim.x * NTHREADS;
        const float* hl = p.in[11]; float* lb = (float*)(ws + WS_LB);
        for (int e = gt; e < 1024; e += GT) lb[e] = sigmoidf_(hl[e] - hl[1024 + e]);
        u32x4* padp = (u32x4*)(ws + WS_WA + (size_t)3616 * 1024 * 2); const u32x4 z = {0u, 0u, 0u, 0u};
        for (int e = gt; e < 224 * 1024 * 2 / 16; e += GT) padp[e] = z;
    }
    {
        LAS float* scr = (LAS float*)(lds + wave * 8448);
        const int gw = blockIdx.x * NWAVES + wave, NGW = gridDim.x * NWAVES;
        const float* w_in = p.in[10];
        bf16* WA = (bf16*)(ws + WS_WA); bf16* WB = (bf16*)(ws + WS_WB);
        constexpr int I1 = 16 * 64, I2 = 16 * 48, I3 = 16 * 1, I4 = 16 * 16, I5 = 16 * 16, I6 = 16 * 64, I7 = 8 * 32, I8 = 8 * 32, I9 = 16 * 32, I10 = 16 * 88, I11 = 16 * 88, I12 = 44 * 32;
        constexpr int NIT = I1 + I2 + I3 + I4 + I5 + I6 + I7 + I8 + I9 + I10 + I11 + I12;
        for (int it = gw; it < NIT; it += NGW) {
            int r = it;
            if (r < I1) { transpose_item(w_in, INW, 0, 2048, 1024, WA, 0, 0, scr, r, lane); continue; } r -= I1;
            if (r < I2) { transpose_item(w_in, INW, 2560, 1536, 1024, WA, 2048, 0, scr, r, lane); continue; } r -= I2;
            if (r < I3) { transpose_item(w_in, INW, 4608, 32, 1024, WA, 3584, 0, scr, r, lane); continue; } r -= I3;
            if (r < I4) { transpose_item(w_in, INW, 2048, 512, 1024, WB, 0, 0, scr, r, lane); continue; } r -= I4;
            if (r < I5) { transpose_item(w_in, INW, 4096, 512, 1024, WB, 512, 0, scr, r, lane); continue; } r -= I5;
            if (r < I6) { transpose_item(w_in, INW, 4640, 2048, 1024, WB, 1024, 0, scr, r, lane); continue; } r -= I6;
            if (r < I7) { transpose_item(p.in[16], 1024, 0, 1024, 512, (bf16*)(ws + WS_WBRH), 0, 0, scr, r, lane); continue; } r -= I7;
            if (r < I8) { transpose_item(p.in[17], 1024, 0, 1024, 512, (bf16*)(ws + WS_WBRG), 0, 0, scr, r, lane); continue; } r -= I8;
            if (r < I9) { transpose_item(p.in[18], 1024, 0, 1024, 1024, (bf16*)(ws + WS_WOUT), 0, 0, scr, r, lane); continue; } r -= I9;
            if (r < I10) { transpose_item(p.in[19], DFF, 0, DFF, 1024, (bf16*)(ws + WS_WGU), 0, 1, scr, r, lane); continue; } r -= I10;
            if (r < I11) { transpose_item(p.in[20], DFF, 0, DFF, 1024, (bf16*)(ws + WS_WGU), 0, 2, scr, r, lane); continue; } r -= I11;
            transpose_item(p.in[21], 1024, 0, 1024, DFF, (bf16*)(ws + WS_WD), 0, 0, scr, r, lane);
        }
    }
}

__device__ __forceinline__ void phase1(const Params& p) {
    const int tid = threadIdx.x, lane = tid & 63, wave = tid >> 6;
    const int gw = blockIdx.x * NWAVES + wave, NGW = gridDim.x * NWAVES;
    const float* x = p.in[0]; const float* ctx = p.in[2]; const float* pre1 = p.in[6];
    const float* modv = (const float*)(p.ws + WS_MODV); bf16* h1 = (bf16*)(p.ws + WS_H1);
    for (int m = gw; m < MALL; m += NGW) {
        const float* src = m < MLAT ? x + (size_t)m * D : ctx + (size_t)(m - MLAT) * D;
        const float* mv = modv + (size_t)(m < MLAT ? m / SEQ : 8) * NMOD;
        f32x4 v[4]; float ss = 0.f;
#pragma unroll
        for (int j = 0; j < 4; ++j) { v[j] = ((const f32x4*)src)[lane + 64 * j]; ss += (v[j][0] * v[j][0] + v[j][1] * v[j][1]) + (v[j][2] * v[j][2] + v[j][3] * v[j][3]); }
        const float rstd = 1.0f / sqrtf(wave_sum(ss) * (1.0f / D) + EPS);
#pragma unroll
        for (int j = 0; j < 4; ++j) {
            const int col = 4 * lane + 256 * j;
            const f32x4 w = *(const f32x4*)(pre1 + col), sh = *(const f32x4*)(mv + col), sc = *(const f32x4*)(mv + 1024 + col);
            f32x4 h;
#pragma unroll
            for (int e = 0; e < 4; ++e) h[e] = v[j][e] * rstd * w[e] * (1.0f + sc[e]) + sh[e];
            u32x2 o; o.x = pk2(h[0], h[1]); o.y = pk2(h[2], h[3]);
            *(u32x2*)(h1 + (size_t)m * D + col) = o;
        }
    }
}

namespace pg8 {
#define PG8_LAS __attribute__((address_space(3)))
typedef unsigned short bf16_t;
typedef short bf16x8 __attribute__((ext_vector_type(8)));
typedef float f32x4 __attribute__((ext_vector_type(4)));
typedef unsigned u32x4 __attribute__((ext_vector_type(4)));
constexpr int BM = 256, BK = 64, HALF = 128, HTB = HALF * BK * 2  , STAGE_BYTES = 8 * HTB, NXCD = 8, WGM = 8;

__host__ __device__ __forceinline__ int lds_byte(int r, int c) { const int st = (r >> 4) * 2 + (c >> 5), rr = r & 15, cc = c & 31, ob = rr * 64 + cc * 2; return st * 1024 + (ob ^ (((ob >> 9) & 1) << 5)); }
__host__ __device__ __forceinline__ void stage_rc(int b, int& R, int& C) { const int st = b / 1024, sb = b % 1024, swz = sb ^ (((sb >> 9) & 1) << 5); R = (st >> 1) * 16 + swz / 64; C = (st & 1) * 32 + (swz % 64) / 2; }
__host__ __device__ __forceinline__ int perm32(int rho) { const int n = rho >> 4, i = rho & 15; return 8 * (i >> 2) + 4 * n + (i & 3); }

struct Unit { int pm, pn; };
struct Gemm { const bf16_t* A; const bf16_t* Bt; int M, N, K, lda; };

struct StaticOrder {
    int nM, nN, nwg, G, c;
    __host__ __device__ void init(int M, int N, int G_, int c_) { nM = M / BM; nN = N / BM; nwg = nM * nN; G = G_; c = c_; }
    __host__ __device__ bool next(int i, Unit& u) const {
        const long L = (long)i * G + c; if (L >= nwg) return false;
        int wgid = (int)L; { const int q = nwg / NXCD, r = nwg % NXCD, xcd = wgid % NXCD, off = wgid / NXCD; wgid = (xcd < r ? xcd * (q + 1) : r * (q + 1) + (xcd - r) * q) + off; }
        const int nig = WGM * nN, gid = wgid / nig, fm = gid * WGM, gsz = (nM - fm) < WGM ? (nM - fm) : WGM;
        u.pm = fm + ((wgid % nig) % gsz); u.pn = (wgid % nig) / gsz; return true;
    }
    __device__ __forceinline__ void a_ready(const Unit&) const {}
    __device__ __forceinline__ void done(const Unit&) const {}
};

__device__ __forceinline__ unsigned cvt_pk_bf16(float lo, float hi) { unsigned r; asm volatile("v_cvt_pk_bf16_f32 %0, %1, %2" : "=v"(r) : "v"(lo), "v"(hi)); return r; }
__device__ __forceinline__ float sigm(float x) { return __builtin_amdgcn_rcpf(1.0f + __expf(-x)); }
__device__ __forceinline__ float lo16(unsigned w) { return __builtin_bit_cast(float, w << 16); }
__device__ __forceinline__ float hi16(unsigned w) { return __builtin_bit_cast(float, w & 0xffff0000u); }

struct EpiStoreBf16 {
    static constexpr bool PERM = true, AFTER_DRAIN = false;
    bf16_t* O; int ldc;
    __device__ __forceinline__ void operator()(const f32x4 (&acc)[2][2][4][2], const Unit& u, int wr, int wc, int fr, int fq) const {
        const int row0 = u.pm * BM + wr * 64 + fr, col0 = u.pn * BM + wc * 32 + 8 * fq;
#pragma unroll
        for (int ai = 0; ai < 2; ++ai)
#pragma unroll
            for (int m = 0; m < 4; ++m) { bf16_t* rowp = O + (size_t)(row0 + ai * HALF + m * 16) * ldc + col0;
#pragma unroll
                for (int bj = 0; bj < 2; ++bj) { const f32x4 v0 = acc[ai][bj][m][0], v1 = acc[ai][bj][m][1];
                    u32x4 w; w.x = cvt_pk_bf16(v0[0], v0[1]); w.y = cvt_pk_bf16(v0[2], v0[3]); w.z = cvt_pk_bf16(v1[0], v1[1]); w.w = cvt_pk_bf16(v1[2], v1[3]);
                    *(u32x4*)(rowp + bj * HALF) = w; } }
    }
};
template <int SECOND> struct EpiBranch {
    static constexpr bool PERM = true, AFTER_DRAIN = false;
    bf16_t* T; int ldt; const bf16_t* G; int ldg; int gcol0;
    __device__ __forceinline__ void operator()(const f32x4 (&acc)[2][2][4][2], const Unit& u, int wr, int wc, int fr, int fq) const {
        const int row0 = u.pm * BM + wr * 64 + fr, col0 = u.pn * BM + wc * 32 + 8 * fq;
#pragma unroll
        for (int ai = 0; ai < 2; ++ai)
#pragma unroll
            for (int m = 0; m < 4; ++m) { const size_t row = (size_t)(row0 + ai * HALF + m * 16);
#pragma unroll
                for (int bj = 0; bj < 2; ++bj) { const f32x4 v0 = acc[ai][bj][m][0], v1 = acc[ai][bj][m][1];
                    const u32x4 g = *(const u32x4*)(G + row * ldg + gcol0 + col0 + bj * HALF);
                    float r[8] = {sigm(lo16(g.x)) * v0[0], sigm(hi16(g.x)) * v0[1], sigm(lo16(g.y)) * v0[2], sigm(hi16(g.y)) * v0[3],
                                  sigm(lo16(g.z)) * v1[0], sigm(hi16(g.z)) * v1[1], sigm(lo16(g.w)) * v1[2], sigm(hi16(g.w)) * v1[3]};
                    bf16_t* tp = T + row * ldt + col0 + bj * HALF;
                    if (SECOND) { const u32x4 t = *(const u32x4*)tp;
                        r[0] += lo16(t.x); r[1] += hi16(t.x); r[2] += lo16(t.y); r[3] += hi16(t.y); r[4] += lo16(t.z); r[5] += hi16(t.z); r[6] += lo16(t.w); r[7] += hi16(t.w); }
                    u32x4 w; w.x = cvt_pk_bf16(r[0], r[1]); w.y = cvt_pk_bf16(r[2], r[3]); w.z = cvt_pk_bf16(r[4], r[5]); w.w = cvt_pk_bf16(r[6], r[7]);
                    *(u32x4*)tp = w; } }
    }
};
struct EpiSwiGLU {
    static constexpr bool PERM = false, AFTER_DRAIN = false;
    bf16_t* ACT; int ldc;
    __device__ __forceinline__ void operator()(const f32x4 (&acc)[2][2][4][2], const Unit& u, int wr, int wc, int fr, int fq) const {
        const int row0 = u.pm * BM + wr * 64 + fr, ch0 = u.pn * HALF + wc * 16 + 4 * fq;
#pragma unroll
        for (int ai = 0; ai < 2; ++ai)
#pragma unroll
            for (int m = 0; m < 4; ++m) { bf16_t* rowp = ACT + (size_t)(row0 + ai * HALF + m * 16) * ldc + ch0;
#pragma unroll
                for (int bj = 0; bj < 2; ++bj) { const f32x4 g = acc[ai][bj][m][0], up = acc[ai][bj][m][1];
                    float r[4];
#pragma unroll
                    for (int e = 0; e < 4; ++e) r[e] = g[e] * sigm(g[e]) * up[e];
                    u32x2 w; w.x = cvt_pk_bf16(r[0], r[1]); w.y = cvt_pk_bf16(r[2], r[3]);
                    *(u32x2*)(rowp + bj * 64) = w; } }
    }
};

template <class Epi, class Sched, bool ALIGN_EPI = false, bool SP2 = false>
__device__ __forceinline__ void gemm_phase(PG8_LAS unsigned char* lds, const Gemm g, const Sched& S, const Epi& E) {
    const int tid = threadIdx.x, wid = __builtin_amdgcn_readfirstlane(tid >> 6), lane = tid & 63, wr = wid >> 2, wc = wid & 3, fr = lane & 15, fq = lane >> 4;
    const int K = g.K, nt = K / BK;
    unsigned voffA[2], voffB[2];
#pragma unroll
    for (int i = 0; i < 2; ++i) { int R, C; stage_rc(tid * 16 + i * 8192, R, C); const int Rb = Epi::PERM ? ((R & ~31) + perm32(R & 31)) : R;
        voffA[i] = (unsigned)(R * g.lda + C) * 2u; voffB[i] = (unsigned)(Rb * K + C) * 2u; }
    const size_t kstep = (size_t)(BK * 2);
    const size_t hstepA = (size_t)HALF * g.lda * 2, hstepB = (size_t)HALF * K * 2;
    const size_t tstepA = 2 * hstepA, tstepB = 2 * hstepB;
    const unsigned ldsw = (unsigned)wid * 1024u;
    const int aoff = lds_byte(wr * 64 + fr, fq * 8), boff = lds_byte(wc * 32 + fr, fq * 8);
#define PG8_SA(b, h) (((b) * 2 + (h)) * HTB)
#define PG8_SB(b, h) ((4 + (b) * 2 + (h)) * HTB)
#define PG8_STAGE(bufoff, gbase, voff) do { _Pragma("unroll") for (int _i = 0; _i < 2; ++_i) \
        __builtin_amdgcn_global_load_lds((const unsigned*)((const char*)(gbase) + (voff)[_i]), (PG8_LAS unsigned*)(lds + (bufoff) + ldsw + _i * 8192), 16, 0, 0); } while (0)
#define PG8_LDA(dst, b, h) do { _Pragma("unroll") for (int m = 0; m < 4; ++m) _Pragma("unroll") for (int k = 0; k < 2; ++k) dst[m][k] = *(const PG8_LAS bf16x8*)(lds + PG8_SA(b, h) + aoff + m * 2048 + k * 1024); } while (0)
#define PG8_LDB(dst, b, h) do { _Pragma("unroll") for (int n = 0; n < 2; ++n) _Pragma("unroll") for (int k = 0; k < 2; ++k) dst[n][k] = *(const PG8_LAS bf16x8*)(lds + PG8_SB(b, h) + boff + n * 2048 + k * 1024); } while (0)
#define PG8_MMA(ai, bj, At, Bt) do { __builtin_amdgcn_s_setprio(1); _Pragma("unroll") for (int m = 0; m < 4; ++m) _Pragma("unroll") for (int n = 0; n < 2; ++n) _Pragma("unroll") for (int k = 0; k < 2; ++k) \
        acc[ai][bj][m][n] = __builtin_amdgcn_mfma_f32_16x16x32_bf16(Bt[n][k], At[m][k], acc[ai][bj][m][n], 0, 0, 0); __builtin_amdgcn_s_setprio(0); } while (0)
#define PG8_WAIT_V(n) asm volatile("s_waitcnt vmcnt(" #n ")" ::: "memory")
#define PG8_WAIT_L(n) asm volatile("s_waitcnt lgkmcnt(" #n ")" ::: "memory")
#define PG8_BAR __builtin_amdgcn_s_barrier()
#define PG8_SCHED __builtin_amdgcn_sched_barrier(0)
    Unit cur, nxt; int ui = 0;
    if (!S.next(0, cur)) return;
    f32x4 acc[2][2][4][2];
#pragma unroll
    for (int a = 0; a < 2; ++a)
#pragma unroll
        for (int b = 0; b < 2; ++b)
#pragma unroll
            for (int m = 0; m < 4; ++m)
#pragma unroll
                for (int n = 0; n < 2; ++n) acc[a][b][m][n] = (f32x4){0.f, 0.f, 0.f, 0.f};
    bf16x8 At[4][2], B0[2][2], B1[2][2];
    const char* cA = (const char*)g.A + (size_t)cur.pm * tstepA; const char* cB = (const char*)g.Bt + (size_t)cur.pn * tstepB;
    S.a_ready(cur);
    if constexpr (SP2) {
        PG8_STAGE(PG8_SB(0, 0), cB, voffB); PG8_STAGE(PG8_SB(0, 1), cB + hstepB, voffB); PG8_STAGE(PG8_SA(0, 0), cA, voffA); PG8_STAGE(PG8_SA(0, 1), cA + hstepA, voffA);
        if (wr == 1) PG8_BAR;
        PG8_WAIT_V(2); PG8_BAR;
        PG8_STAGE(PG8_SB(1, 0), cB + kstep, voffB); PG8_STAGE(PG8_SA(1, 0), cA + kstep, voffA); PG8_STAGE(PG8_SB(1, 1), cB + hstepB + kstep, voffB);
        PG8_WAIT_V(6); PG8_BAR;
    } else {
        PG8_STAGE(PG8_SB(0, 0), cB, voffB); PG8_STAGE(PG8_SA(0, 0), cA, voffA); PG8_STAGE(PG8_SB(0, 1), cB + hstepB, voffB); PG8_STAGE(PG8_SA(0, 1), cA + hstepA, voffA);
        if (wr == 1) PG8_BAR;
        PG8_WAIT_V(4); PG8_BAR;
        PG8_STAGE(PG8_SB(1, 0), cB + kstep, voffB); PG8_STAGE(PG8_SA(1, 0), cA + kstep, voffA); PG8_STAGE(PG8_SB(1, 1), cB + hstepB + kstep, voffB);
        PG8_WAIT_V(6); PG8_BAR;
    }
    for (;;) {
        const bool has_next = S.next(ui + 1, nxt);
        const char* nA = has_next ? (const char*)g.A + (size_t)nxt.pm * tstepA : cA; const char* nB = has_next ? (const char*)g.Bt + (size_t)nxt.pn * tstepB : cB;
        for (int t = 0; t < nt; t += 2) {
            const bool last = (t == nt - 2);
            const char* a1 = cA + (size_t)(t + 1) * kstep;
            const char* a2 = last ? nA : cA + (size_t)(t + 2) * kstep; const char* b2 = last ? nB : cB + (size_t)(t + 2) * kstep;
            const char* a3 = a2 + kstep; const char* b3 = b2 + kstep;
            if (last && has_next) S.a_ready(nxt);
            if constexpr (SP2) {
            PG8_LDB(B0, 0, 0); PG8_LDB(B1, 0, 1); PG8_SCHED; PG8_LDA(At, 0, 0); PG8_STAGE(PG8_SA(1, 1), a1 + hstepA, voffA);
            PG8_WAIT_V(8); PG8_WAIT_L(0); PG8_BAR; PG8_MMA(0, 0, At, B0); PG8_MMA(0, 1, At, B1); PG8_BAR; PG8_SCHED;
            PG8_LDA(At, 0, 1); PG8_STAGE(PG8_SB(0, 0), b2, voffB); PG8_STAGE(PG8_SB(0, 1), b2 + hstepB, voffB); PG8_STAGE(PG8_SA(0, 0), a2, voffA);
            PG8_WAIT_V(8); PG8_WAIT_L(0); PG8_BAR; PG8_MMA(1, 0, At, B0); PG8_MMA(1, 1, At, B1); PG8_BAR; PG8_SCHED;
            PG8_LDB(B0, 1, 0); PG8_LDB(B1, 1, 1); PG8_SCHED; PG8_LDA(At, 1, 0); PG8_STAGE(PG8_SA(0, 1), a2 + hstepA, voffA);
            PG8_WAIT_V(8); PG8_WAIT_L(0); PG8_BAR; PG8_MMA(0, 0, At, B0); PG8_MMA(0, 1, At, B1); PG8_BAR; PG8_SCHED;
            PG8_LDA(At, 1, 1); PG8_STAGE(PG8_SB(1, 0), b3, voffB); PG8_STAGE(PG8_SB(1, 1), b3 + hstepB, voffB); PG8_STAGE(PG8_SA(1, 0), a3, voffA);
            PG8_WAIT_V(8); PG8_WAIT_L(0); PG8_BAR; PG8_MMA(1, 0, At, B0); PG8_MMA(1, 1, At, B1); PG8_BAR; PG8_SCHED;
            } else {
            PG8_LDB(B0, 0, 0); PG8_SCHED; PG8_LDA(At, 0, 0); PG8_STAGE(PG8_SA(1, 1), a1 + hstepA, voffA);
            PG8_WAIT_L(8); PG8_BAR; PG8_WAIT_L(0); PG8_MMA(0, 0, At, B0); PG8_BAR; PG8_SCHED;
            PG8_LDB(B1, 0, 1); PG8_STAGE(PG8_SB(0, 0), b2, voffB);
            PG8_BAR; PG8_WAIT_L(0); PG8_MMA(0, 1, At, B1); PG8_BAR;
            PG8_LDA(At, 0, 1); PG8_STAGE(PG8_SA(0, 0), a2, voffA);
            PG8_BAR; PG8_WAIT_L(0); PG8_MMA(1, 0, At, B0); PG8_BAR; PG8_SCHED;
            PG8_STAGE(PG8_SB(0, 1), b2 + hstepB, voffB);
            PG8_WAIT_V(6); PG8_BAR; PG8_MMA(1, 1, At, B1); PG8_BAR;
            PG8_LDB(B0, 1, 0); PG8_SCHED; PG8_LDA(At, 1, 0); PG8_STAGE(PG8_SA(0, 1), a2 + hstepA, voffA);
            PG8_WAIT_L(8); PG8_BAR; PG8_WAIT_L(0); PG8_MMA(0, 0, At, B0); PG8_BAR; PG8_SCHED;
            PG8_LDB(B1, 1, 1); PG8_STAGE(PG8_SB(1, 0), b3, voffB);
            PG8_BAR; PG8_WAIT_L(0); PG8_MMA(0, 1, At, B1); PG8_BAR;
            PG8_LDA(At, 1, 1); PG8_STAGE(PG8_SA(1, 0), a3, voffA);
            PG8_BAR; PG8_WAIT_L(0); PG8_MMA(1, 0, At, B0); PG8_BAR; PG8_SCHED;
            PG8_STAGE(PG8_SB(1, 1), b3 + hstepB, voffB);
            PG8_WAIT_V(6); PG8_BAR; PG8_MMA(1, 1, At, B1); PG8_BAR;
            }
        }
        if constexpr (ALIGN_EPI) { if (wr == 0) PG8_BAR; }
        if constexpr (!Epi::AFTER_DRAIN) { E(acc, cur, wr, wc, fr, fq); S.done(cur); }
        if (!has_next) break;
#pragma unroll
        for (int a = 0; a < 2; ++a)
#pragma unroll
            for (int b = 0; b < 2; ++b)
#pragma unroll
                for (int m = 0; m < 4; ++m)
#pragma unroll
                    for (int n = 0; n < 2; ++n) acc[a][b][m][n] = (f32x4){0.f, 0.f, 0.f, 0.f};
        cur = nxt; cA = nA; cB = nB; ++ui;
        if constexpr (ALIGN_EPI) { if (wr == 1) PG8_BAR; }
    }
    PG8_WAIT_V(0);
    if constexpr (!ALIGN_EPI) { if (wr == 0) PG8_BAR; }
    PG8_BAR;
    if constexpr (Epi::AFTER_DRAIN) { E.fused(acc, cur, wr, wc, fr, fq, lds, wid, lane); S.done(cur); }
#undef PG8_SA
#undef PG8_SB
#undef PG8_STAGE
#undef PG8_LDA
#undef PG8_LDB
#undef PG8_MMA
#undef PG8_WAIT_V
#undef PG8_WAIT_L
#undef PG8_BAR
#undef PG8_SCHED
}
}

__device__ __forceinline__ void phase3(const Params& p, LAS unsigned char* lds) {
    const int tid = threadIdx.x;
    const bf16* PA = (const bf16*)(p.ws + WS_PA);
    const float* lbv = (const float*)(p.ws + WS_LB);
    bf16* O = (bf16*)p.out;
    LAS float* sq = (LAS float*)lds;
    LAS float* sf = sq + 2048;
    LAS float* sk = sf + 2048;
    LAS float* sv = sk + 2048;
    LAS float* red = sv + 2048;
    const int c = tid & 127, kg = tid >> 7;
    const int lj = tid >> 5, k4 = (tid & 31) * 4;
    for (int it = blockIdx.x; it < 128; it += gridDim.x) {
        const int b = it & 7, hh = (it >> 3) & 3, dir = (it >> 5) & 1, br = it >> 6;
        float S[32];
#pragma unroll
        for (int k = 0; k < 32; ++k) S[k] = 0.f;
        const int qcol = (br ? 2048 : 0) + hh * 128;
        const int fcol = br ? 2560 + hh * 128 : 1024 + dir * 512 + hh * 128;
        const int vcol = (br ? 3072 : 512) + hh * 128;
        const int lrcol = 3584 + dir * 16;
        f32x4 lb4 = {0.f, 0.f, 0.f, 0.f}, bg4 = {0.f, 0.f, 0.f, 0.f};
        if (br == 0) lb4 = *(const f32x4*)(lbv + dir * 512 + hh * 128 + k4);
        else bg4 = *(const f32x4*)(p.in[14] + dir * 512 + hh * 128 + k4);
#pragma unroll 1
        for (int step = 0; step < (CTXL + SEQ) / 16; ++step) {
            __syncthreads();
            {
                const int pos = step * 16 + lj;
                int row;
                if (pos < CTXL) row = MLAT + b * CTXL + (dir ? CTXL - 1 - pos : pos);
                else { const int t = pos - CTXL; row = b * SEQ + (dir ? SEQ - 1 - t : t); }
                const bf16* pr = PA + (size_t)row * NA;
                const u32x2 q2 = *(const u32x2*)(pr + qcol + k4), f2 = *(const u32x2*)(pr + fcol + k4), v2 = *(const u32x2*)(pr + vcol + k4);
                f32x4 qv = {bflo(q2.x), bfhi(q2.x), bflo(q2.y), bfhi(q2.y)};
                f32x4 fv = {bflo(f2.x), bfhi(f2.x), bflo(f2.y), bfhi(f2.y)};
                const f32x4 vv = {bflo(v2.x), bfhi(v2.x), bflo(v2.y), bfhi(v2.y)};
                f32x4 kv;
                if (br == 0) {
#pragma unroll
                    for (int e = 0; e < 4; ++e) { const float f = lb4[e] + (1.0f - lb4[e]) * sigmoidf_(fv[e]); kv[e] = 1.0f - f; fv[e] = f; qv[e] = siluf_(qv[e]); }
                } else {
                    const u32x4 l0 = *(const u32x4*)(pr + lrcol), l1 = *(const u32x4*)(pr + lrcol + 8);
                    const float lr[16] = {bflo(l0.x), bfhi(l0.x), bflo(l0.y), bfhi(l0.y), bflo(l0.z), bfhi(l0.z), bflo(l0.w), bfhi(l0.w),
                                          bflo(l1.x), bfhi(l1.x), bflo(l1.y), bfhi(l1.y), bflo(l1.z), bfhi(l1.z), bflo(l1.w), bfhi(l1.w)};
                    f32x4 xg = bg4;
                    const float* wgp = p.in[13] + (size_t)(dir * 16) * 512 + hh * 128 + k4;
                    asm volatile("" : "+v"(wgp));
#pragma unroll
                    for (int r = 0; r < 16; ++r) xg += lr[r] * *(const f32x4*)(wgp + r * 512);
                    kv = fv;
#pragma unroll
                    for (int e = 0; e < 4; ++e) {
                        const float ls = fminf(xg[e], 0.f) - log1pf(__expf(-fabsf(xg[e])));
                        fv[e] = __expf(ls * (1.0f / 16.0f)); qv[e] *= 0.08838834764831845f;
                    }
                }
                *(LAS f32x4*)(sq + lj * 128 + k4) = qv; *(LAS f32x4*)(sf + lj * 128 + k4) = fv; *(LAS f32x4*)(sk + lj * 128 + k4) = kv; *(LAS f32x4*)(sv + lj * 128 + k4) = vv;
            }
            __syncthreads();
#pragma unroll 1
            for (int j = 0; j < 16; ++j) {
                const float vc = sv[j * 128 + c];
                float acc = 0.f;
#pragma unroll
                for (int k = 0; k < 32; k += 4) {
                    const f32x4 f4 = *(const LAS f32x4*)(sf + j * 128 + kg * 32 + k), k4v = *(const LAS f32x4*)(sk + j * 128 + kg * 32 + k), q4 = *(const LAS f32x4*)(sq + j * 128 + kg * 32 + k);
#pragma unroll
                    for (int e = 0; e < 4; ++e) { S[k + e] = f4[e] * S[k + e] + k4v[e] * vc; acc += q4[e] * S[k + e]; }
                }
                red[(kg * 16 + j) * 128 + c] = acc;
            }
            __syncthreads();
            if (step * 16 >= CTXL) {
                const int t = step * 16 + lj - CTXL;
                const int row = b * SEQ + (dir ? SEQ - 1 - t : t);
                f32x4 o = *(const LAS f32x4*)(red + (0 * 16 + lj) * 128 + k4);
                o += *(const LAS f32x4*)(red + (1 * 16 + lj) * 128 + k4);
                o += *(const LAS f32x4*)(red + (2 * 16 + lj) * 128 + k4);
                o += *(const LAS f32x4*)(red + (3 * 16 + lj) * 128 + k4);
                u32x2 w; w.x = pk2(o[0], o[1]); w.y = pk2(o[2], o[3]);
                *(u32x2*)(O + ((size_t)(br * 2 + dir) * MLAT + row) * 512 + hh * 128 + k4) = w;
            }
        }
        __syncthreads();
    }
}

__device__ __forceinline__ void phase5(const Params& p) {
    const int tid = threadIdx.x, lane = tid & 63, wave = tid >> 6;
    const int gw = blockIdx.x * NWAVES + wave, NGW = gridDim.x * NWAVES;
    const bf16* O = (const bf16*)p.out; const bf16* PB = (const bf16*)(p.ws + WS_PA); bf16* A12 = (bf16*)(p.ws + WS_A12);
    for (int m = gw; m < MLAT; m += NGW) {
#pragma unroll
        for (int hd = 0; hd < 8; ++hd) {
            const int br = hd >> 2, col = (hd & 3) * 128 + 2 * lane;
            const unsigned a = *(const unsigned*)(O + ((size_t)(br * 2 + 0) * MLAT + m) * 512 + col), bq = *(const unsigned*)(O + ((size_t)(br * 2 + 1) * MLAT + m) * 512 + col);
            const float o0 = bflo(a) + bflo(bq), o1 = bfhi(a) + bfhi(bq);
            const float rstd = 1.0f / sqrtf(wave_sum(o0 * o0 + o1 * o1) * (1.0f / 128.0f) + EPS);
            const unsigned g = *(const unsigned*)(PB + (size_t)m * NBB + br * 512 + col);
            const float* on = (br ? p.in[15] : p.in[12]) + 2 * lane;
            const float r0 = o0 * rstd * on[0] * siluf_(bflo(g)), r1 = o1 * rstd * on[1] * siluf_(bfhi(g));
            *(unsigned*)(A12 + (size_t)m * D + hd * 128 + 2 * lane) = pk2(r0, r1);
        }
    }
}

__device__ __forceinline__ void phase8(const Params& p) {
    const int tid = threadIdx.x, lane = tid & 63, wave = tid >> 6;
    const int gw = blockIdx.x * NWAVES + wave, NGW = gridDim.x * NWAVES;
    const float* x = p.in[0]; const float* post1 = p.in[7]; const float* pre2 = p.in[8];
    const float* modv = (const float*)(p.ws + WS_MODV); const bf16* y1 = (const bf16*)(p.ws + WS_Y1); bf16* h2 = (bf16*)(p.ws + WS_H1);
    for (int m = gw; m < MLAT; m += NGW) {
        const float* mv = modv + (size_t)(m / SEQ) * NMOD;
        f32x4 y[4], z[4]; float ss = 0.f;
#pragma unroll
        for (int j = 0; j < 4; ++j) {
            const u32x2 w = *(const u32x2*)(y1 + (size_t)m * D + 4 * lane + 256 * j);
            y[j] = (f32x4){bflo(w.x), bfhi(w.x), bflo(w.y), bfhi(w.y)};
            ss += (y[j][0] * y[j][0] + y[j][1] * y[j][1]) + (y[j][2] * y[j][2] + y[j][3] * y[j][3]);
        }
        const float rstd1 = 1.0f / sqrtf(wave_sum(ss) * (1.0f / D) + EPS);
        float s2 = 0.f;
#pragma unroll
        for (int j = 0; j < 4; ++j) {
            const int col = 4 * lane + 256 * j;
            const f32x4 xv = *(const f32x4*)(x + (size_t)m * D + col), w = *(const f32x4*)(post1 + col), g = *(const f32x4*)(mv + 2048 + col);
#pragma unroll
            for (int e = 0; e < 4; ++e) { z[j][e] = xv[e] + g[e] * (y[j][e] * rstd1 * w[e]); s2 += z[j][e] * z[j][e]; }
            *(f32x4*)(p.out + (size_t)m * D + col) = z[j];
        }
        const float rstdz = 1.0f / sqrtf(wave_sum(s2) * (1.0f / D) + EPS);
#pragma unroll
        for (int j = 0; j < 4; ++j) {
            const int col = 4 * lane + 256 * j;
            const f32x4 w = *(const f32x4*)(pre2 + col), sh = *(const f32x4*)(mv + 3072 + col), sc = *(const f32x4*)(mv + 4096 + col);
            f32x4 h;
#pragma unroll
            for (int e = 0; e < 4; ++e) h[e] = z[j][e] * rstdz * w[e] * (1.0f + sc[e]) + sh[e];
            u32x2 o; o.x = pk2(h[0], h[1]); o.y = pk2(h[2], h[3]);
            *(u32x2*)(h2 + (size_t)m * D + col) = o;
        }
    }
}

__device__ __forceinline__ void phase11(const Params& p) {
    const int tid = threadIdx.x, lane = tid & 63, wave = tid >> 6;
    const int gw = blockIdx.x * NWAVES + wave, NGW = gridDim.x * NWAVES;
    const float* post2 = p.in[9];
    const float* modv = (const float*)(p.ws + WS_MODV); const bf16* y2 = (const bf16*)(p.ws + WS_A12);
    for (int m = gw; m < MLAT; m += NGW) {
        const float* mv = modv + (size_t)(m / SEQ) * NMOD;
        f32x4 y[4]; float ss = 0.f;
#pragma unroll
        for (int j = 0; j < 4; ++j) {
            const u32x2 w = *(const u32x2*)(y2 + (size_t)m * D + 4 * lane + 256 * j);
            y[j] = (f32x4){bflo(w.x), bfhi(w.x), bflo(w.y), bfhi(w.y)};
            ss += (y[j][0] * y[j][0] + y[j][1] * y[j][1]) + (y[j][2] * y[j][2] + y[j][3] * y[j][3]);
        }
        const float rstd2 = 1.0f / sqrtf(wave_sum(ss) * (1.0f / D) + EPS);
#pragma unroll
        for (int j = 0; j < 4; ++j) {
            const int col = 4 * lane + 256 * j;
            const f32x4 w = *(const f32x4*)(post2 + col), g = *(const f32x4*)(mv + 5120 + col);
            f32x4 z = *(const f32x4*)(p.out + (size_t)m * D + col);
#pragma unroll
            for (int e = 0; e < 4; ++e) z[e] += g[e] * (y[j][e] * rstd2 * w[e]);
            *(f32x4*)(p.out + (size_t)m * D + col) = z;
        }
    }
}

__global__ void __launch_bounds__(NTHREADS, 2) fwd_kernel(Params p) {
    extern __shared__ __attribute__((aligned(16))) unsigned char lds_raw[];
    LAS unsigned char* lds = (LAS unsigned char*)lds_raw;
    cg::grid_group grid = cg::this_grid();
    unsigned char* ws = p.ws;
    const int lo = p.ph_lo, hi = p.ph_hi;
#define IN(k) (lo <= (k) && (k) < hi)
#define SYNC(k) do { if (IN(k) && IN((k) + 1)) grid.sync(); } while (0)
    if (IN(0)) phase0(p, lds);
    SYNC(0);
    if (IN(1)) phase1(p);
    SYNC(1);
    if (IN(2)) { pg8::Gemm g{(const bf16*)(ws + WS_H1), (const bf16*)(ws + WS_WA), MALL, NA, D, D}; pg8::StaticOrder S; S.init(MALL, NA, (int)gridDim.x, (int)blockIdx.x);
        pg8::EpiStoreBf16 e{(bf16*)(ws + WS_PA), NA}; pg8::gemm_phase<pg8::EpiStoreBf16, pg8::StaticOrder, true, true>(lds, g, S, e); }
    SYNC(2);
    if (IN(3)) phase3(p, lds);
    SYNC(3);
    if (IN(4)) { pg8::Gemm g{(const bf16*)(ws + WS_H1), (const bf16*)(ws + WS_WB), MLAT, NBB, D, D}; pg8::StaticOrder S; S.init(MLAT, NBB, (int)gridDim.x, (int)blockIdx.x);
        pg8::EpiStoreBf16 e{(bf16*)(ws + WS_PA), NBB}; pg8::gemm_phase<pg8::EpiStoreBf16, pg8::StaticOrder, true, true>(lds, g, S, e); }
    SYNC(4);
    if (IN(5)) phase5(p);
    SYNC(5);
    if (IN(6)) {
        pg8::StaticOrder S; S.init(MLAT, D, (int)gridDim.x, (int)blockIdx.x);
        { pg8::Gemm g{(const bf16*)(ws + WS_A12), (const bf16*)(ws + WS_WBRH), MLAT, D, 512, D};
          pg8::EpiBranch<0> e{(bf16*)(ws + WS_H1), D, (const bf16*)(ws + WS_PA), NBB, 1024}; pg8::gemm_phase<pg8::EpiBranch<0>, pg8::StaticOrder, true, true>(lds, g, S, e); }
        { pg8::Gemm g{(const bf16*)(ws + WS_A12) + 512, (const bf16*)(ws + WS_WBRG), MLAT, D, 512, D};
          pg8::EpiBranch<1> e{(bf16*)(ws + WS_H1), D, (const bf16*)(ws + WS_PA), NBB, 2048}; pg8::gemm_phase<pg8::EpiBranch<1>, pg8::StaticOrder, true, true>(lds, g, S, e); }
    }
    SYNC(6);
    if (IN(7)) { pg8::Gemm g{(const bf16*)(ws + WS_H1), (const bf16*)(ws + WS_WOUT), MLAT, D, D, D}; pg8::StaticOrder S; S.init(MLAT, D, (int)gridDim.x, (int)blockIdx.x);
        pg8::EpiStoreBf16 e{(bf16*)(ws + WS_Y1), D}; pg8::gemm_phase<pg8::EpiStoreBf16, pg8::StaticOrder, true, true>(lds, g, S, e); }
    SYNC(7);
    if (IN(8)) phase8(p);
    SYNC(8);
    if (IN(9)) { pg8::Gemm g{(const bf16*)(ws + WS_H1), (const bf16*)(ws + WS_WGU), MLAT, NGU, D, D}; pg8::StaticOrder S; S.init(MLAT, NGU, (int)gridDim.x, (int)blockIdx.x);
        pg8::EpiSwiGLU e{(bf16*)(ws + WS_PA), DFF}; pg8::gemm_phase<pg8::EpiSwiGLU, pg8::StaticOrder, true, true>(lds, g, S, e); }
    SYNC(9);
    if (IN(10)) { pg8::Gemm g{(const bf16*)(ws + WS_PA), (const bf16*)(ws + WS_WD), MLAT, D, DFF, DFF}; pg8::StaticOrder S; S.init(MLAT, D, (int)gridDim.x, (int)blockIdx.x);
        pg8::EpiStoreBf16 e{(bf16*)(ws + WS_A12), D}; pg8::gemm_phase<pg8::EpiStoreBf16, pg8::StaticOrder, true, true>(lds, g, S, e); }
    SYNC(10);
    if (IN(11)) phase11(p);
#undef IN
#undef SYNC
}

extern "C" void kernel_launch(void* const* d_in, const int* in_sizes, int n_in, void* d_out, int out_size, void* d_ws, size_t ws_size, hipStream_t stream) {
    static int grid = 0;
    if (grid == 0) {
        if (n_in != 22 || out_size != MLAT * D || ws_size < WS_END) { fprintf(stderr, "kernel_launch: unexpected shapes (n_in %d out %d ws %zu)\n", n_in, out_size, ws_size); grid = -1; return; }
        int dev = 0, cus = 0, per_cu = 0;
        hipGetDevice(&dev);
        hipDeviceGetAttribute(&cus, hipDeviceAttributeMultiprocessorCount, dev);
        hipFuncSetAttribute((const void*)fwd_kernel, hipFuncAttributeMaxDynamicSharedMemorySize, LDS_BYTES);
        hipOccupancyMaxActiveBlocksPerMultiprocessor(&per_cu, (const void*)fwd_kernel, NTHREADS, LDS_BYTES);
        if (per_cu < 1) { fprintf(stderr, "kernel_launch: occupancy query says %d blocks/CU\n", per_cu); per_cu = 1; }
        grid = cus * 1;
        (void)hipGetLastError();
    }
    if (grid < 0) return;
    Params p{};
    for (int i = 0; i < 22; ++i) p.in[i] = (const float*)d_in[i];
    p.out = (float*)d_out; p.ws = (unsigned char*)d_ws; p.ph_lo = 0; p.ph_hi = 12;
    void* args[] = {&p};
    hipError_t e = hipLaunchCooperativeKernel((const void*)fwd_kernel, dim3(grid), dim3(NTHREADS), args, LDS_BYTES, stream);
    if (e != hipSuccess) fprintf(stderr, "cooperative launch failed: %s (grid %d)\n", hipGetErrorString(e), grid);
}
```

```cpp
#include <hip/hip_runtime.h>
#include <hip/hip_cooperative_groups.h>
#include <cstdio>
#include <cstdint>
namespace cg = cooperative_groups;

typedef unsigned short bf16;
typedef short bf16x8 __attribute__((ext_vector_type(8)));
typedef float f32x4 __attribute__((ext_vector_type(4)));
typedef unsigned u32x4 __attribute__((ext_vector_type(4)));
typedef unsigned u32x2 __attribute__((ext_vector_type(2)));
#define LAS __attribute__((address_space(3)))

constexpr int NB = 8, SEQ = 2048, CTXL = 256, D = 1024, DFF = 2816;
constexpr int MLAT = NB * SEQ, MCTX = NB * CTXL, MALL = MLAT + MCTX;
constexpr int INW = 6688, NMOD = 6144;
constexpr int NA = 3840;
constexpr int NBB = 3072;
constexpr int NGU = 2 * DFF;
constexpr float EPS = 1e-6f;
constexpr int NWAVES = 8, NTHREADS = 512;
constexpr int LDS_BYTES = 147456;

constexpr size_t MiB = 1u << 20;
constexpr size_t WS_CTL = 0;
constexpr size_t WS_MODV = 1 * MiB;
constexpr size_t WS_LB = WS_MODV + 512 * 1024;
constexpr size_t WS_WA = 2 * MiB;
constexpr size_t WS_WB = 10 * MiB;
constexpr size_t WS_WBRH = 16 * MiB;
constexpr size_t WS_WBRG = 17 * MiB;
constexpr size_t WS_WOUT = 18 * MiB;
constexpr size_t WS_WGU = 20 * MiB;
constexpr size_t WS_WD = 31 * MiB;
constexpr size_t WS_H1 = 37 * MiB;
constexpr size_t WS_PA = 73 * MiB;
constexpr size_t WS_A12 = 169 * MiB;
constexpr size_t WS_Y1 = 201 * MiB;
constexpr size_t WS_END = 233 * MiB;

struct Params {
    const float* in[22];
    float* out;
    unsigned char* ws;
    int ph_lo, ph_hi;
};

__device__ __forceinline__ unsigned f2bf(float f) { unsigned u = __builtin_bit_cast(unsigned, f); return (u + 0x7fffu + ((u >> 16) & 1u)) >> 16; }
__device__ __forceinline__ unsigned pk2(float lo, float hi) { return f2bf(lo) | (f2bf(hi) << 16); }
__device__ __forceinline__ float bf2f(unsigned b) { return __builtin_bit_cast(float, b << 16); }
__device__ __forceinline__ float bflo(unsigned w) { return __builtin_bit_cast(float, w << 16); }
__device__ __forceinline__ float bfhi(unsigned w) { return __builtin_bit_cast(float, w & 0xffff0000u); }
__device__ __forceinline__ float sigmoidf_(float x) { return 1.0f / (1.0f + __expf(-x)); }
__device__ __forceinline__ float siluf_(float x) { return x / (1.0f + __expf(-x)); }
__device__ __forceinline__ float wave_sum(float v) {
#pragma unroll
    for (int o = 1; o < 64; o <<= 1) v += __shfl_xor(v, o);
    return v;
}

__device__ __forceinline__ void transpose_item(const float* W, int ldw, int c0, int ncols, int Kdst, bf16* WT, int row0, int mode, LAS float* scr, int item, int lane) {
    const int nblk = ncols / 32, kb = item / nblk, nb = item % nblk, k0 = 64 * kb, n0 = 32 * nb;
#pragma unroll 8
    for (int i = 0; i < 32; ++i) { const int kk = 2 * i + (lane >> 5); scr[kk * 33 + (lane & 31)] = W[(size_t)(k0 + kk) * ldw + c0 + n0 + (lane & 31)]; }
    asm volatile("s_waitcnt lgkmcnt(0)" ::: "memory");
    const int c = lane & 7;
#pragma unroll
    for (int j = 0; j < 4; ++j) {
        const int n = (lane >> 3) + 8 * j; const LAS float* s = scr + (8 * c) * 33 + n;
        u32x4 o; o.x = pk2(s[0 * 33], s[1 * 33]); o.y = pk2(s[2 * 33], s[3 * 33]); o.z = pk2(s[4 * 33], s[5 * 33]); o.w = pk2(s[6 * 33], s[7 * 33]);
        const int nn = n0 + n;
        const int drow = mode == 0 ? row0 + nn : (2 * (nn & ~15) + (nn & 15) + (mode == 2 ? 16 : 0));
        *(u32x4*)(WT + (size_t)drow * Kdst + k0 + 8 * c) = o;
    }
    asm volatile("s_waitcnt lgkmcnt(0)" ::: "memory");
}

__device__ __forceinline__ void phase0(const Params& p, LAS unsigned char* lds) {
    const int tid = threadIdx.x, lane = tid & 63, wave = tid >> 6;
    unsigned char* ws = p.ws;
    {
        LAS float* sil = (LAS float*)lds;
        LAS float* red = (LAS float*)(lds + 49152);
        const float* cv = p.in[1]; const float* cc = p.in[3]; const float* wm = p.in[4]; const float* bm = p.in[5];
        float* modv = (float*)(ws + WS_MODV);
        for (int it = blockIdx.x; it < NMOD / 64; it += gridDim.x) {
            __syncthreads();
            for (int e = tid; e < 9 * 1024; e += NTHREADS) { const int r = e >> 10, k = e & 1023; const float v = r < 8 ? cv[r * 1024 + k] : cc[k]; sil[k * 12 + r] = siluf_(v); }
            __syncthreads();
            const int j = it * 64 + lane;
            float acc[9];
#pragma unroll
            for (int r = 0; r < 9; ++r) acc[r] = 0.f;
            const int kbeg = wave * 128;
#pragma unroll 4
            for (int k = kbeg; k < kbeg + 128; ++k) {
                const float w = wm[(size_t)k * NMOD + j];
                const f32x4 s0 = *(const LAS f32x4*)(sil + k * 12), s1 = *(const LAS f32x4*)(sil + k * 12 + 4); const float s8 = sil[k * 12 + 8];
                acc[0] += s0[0] * w; acc[1] += s0[1] * w; acc[2] += s0[2] * w; acc[3] += s0[3] * w;
                acc[4] += s1[0] * w; acc[5] += s1[1] * w; acc[6] += s1[2] * w; acc[7] += s1[3] * w; acc[8] += s8 * w;
            }
#pragma unroll
            for (int r = 0; r < 9; ++r) red[(wave * 9 + r) * 64 + lane] = acc[r];
            __syncthreads();
            for (int e = tid; e < 9 * 64; e += NTHREADS) {
                const int r = e >> 6, l = e & 63; float s = 0.f;
#pragma unroll
                for (int w2 = 0; w2 < 8; ++w2) s += red[(w2 * 9 + r) * 64 + l];
                modv[(size_t)r * NMOD + it * 64 + l] = s + bm[it * 64 + l];
            }
        }
        __syncthreads();
    }
    {
        const int gt = blockIdx.x * NTHREADS + tid, GT = gridDim.x * NTHREADS;
        const float* hl = p.in[11]; float* lb = (float*)(ws + WS_LB);
        for (int e = gt; e < 1024; e += GT) lb[e] = sigmoidf_(hl[e] - hl[1024 + e]);
        u32x4* padp = (u32x4*)(ws + WS_WA + (size_t)3616 * 1024 * 2); const u32x4 z = {0u, 0u, 0u, 0u};
        for (int e = gt; e < 224 * 1024 * 2 / 16; e += GT) padp[e] = z;
    }
    {
        LAS float* scr = (LAS float*)(lds + wave * 8448);
        const int gw = blockIdx.x * NWAVES + wave, NGW = gridDim.x * NWAVES;
        const float* w_in = p.in[10];
        bf16* WA = (bf16*)(ws + WS_WA); bf16* WB = (bf16*)(ws + WS_WB);
        constexpr int I1 = 16 * 64, I2 = 16 * 48, I3 = 16 * 1, I4 = 16 * 16, I5 = 16 * 16, I6 = 16 * 64, I7 = 8 * 32, I8 = 8 * 32, I9 = 16 * 32, I10 = 16 * 88, I11 = 16 * 88, I12 = 44 * 32;
        constexpr int NIT = I1 + I2 + I3 + I4 + I5 + I6 + I7 + I8 + I9 + I10 + I11 + I12;
        for (int it = gw; it < NIT; it += NGW) {
            int r = it;
            if (r < I1) { transpose_item(w_in, INW, 0, 2048, 1024, WA, 0, 0, scr, r, lane); continue; } r -= I1;
            if (r < I2) { transpose_item(w_in, INW, 2560, 1536, 1024, WA, 2048, 0, scr, r, lane); continue; } r -= I2;
            if (r < I3) { transpose_item(w_in, INW, 4608, 32, 1024, WA, 3584, 0, scr, r, lane); continue; } r -= I3;
            if (r < I4) { transpose_item(w_in, INW, 2048, 512, 1024, WB, 0, 0, scr, r, lane); continue; } r -= I4;
            if (r < I5) { transpose_item(w_in, INW, 4096, 512, 1024, WB, 512, 0, scr, r, lane); continue; } r -= I5;
            if (r < I6) { transpose_item(w_in, INW, 4640, 2048, 1024, WB, 1024, 0, scr, r, lane); continue; } r -= I6;
            if (r < I7) { transpose_item(p.in[16], 1024, 0, 1024, 512, (bf16*)(ws + WS_WBRH), 0, 0, scr, r, lane); continue; } r -= I7;
            if (r < I8) { transpose_item(p.in[17], 1024, 0, 1024, 512, (bf16*)(ws + WS_WBRG), 0, 0, scr, r, lane); continue; } r -= I8;
            if (r < I9) { transpose_item(p.in[18], 1024, 0, 1024, 1024, (bf16*)(ws + WS_WOUT), 0, 0, scr, r, lane); continue; } r -= I9;
            if (r < I10) { transpose_item(p.in[19], DFF, 0, DFF, 1024, (bf16*)(ws + WS_WGU), 0, 1, scr, r, lane); continue; } r -= I10;
            if (r < I11) { transpose_item(p.in[20], DFF, 0, DFF, 1024, (bf16*)(ws + WS_WGU), 0, 2, scr, r, lane); continue; } r -= I11;
            transpose_item(p.in[21], 1024, 0, 1024, DFF, (bf16*)(ws + WS_WD), 0, 0, scr, r, lane);
        }
    }
}

__device__ __forceinline__ void phase1(const Params& p) {
    const int tid = threadIdx.x, lane = tid & 63, wave = tid >> 6;
    const int gw = blockIdx.x * NWAVES + wave, NGW = gridDim.x * NWAVES;
    const float* x = p.in[0]; const float* ctx = p.in[2]; const float* pre1 = p.in[6];
    const float* modv = (const float*)(p.ws + WS_MODV); bf16* h1 = (bf16*)(p.ws + WS_H1);
    for (int m = gw; m < MALL; m += NGW) {
        const float* src = m < MLAT ? x + (size_t)m * D : ctx + (size_t)(m - MLAT) * D;
        const float* mv = modv + (size_t)(m < MLAT ? m / SEQ : 8) * NMOD;
        f32x4 v[4]; float ss = 0.f;
#pragma unroll
        for (int j = 0; j < 4; ++j) { v[j] = ((const f32x4*)src)[lane + 64 * j]; ss += (v[j][0] * v[j][0] + v[j][1] * v[j][1]) + (v[j][2] * v[j][2] + v[j][3] * v[j][3]); }
        const float rstd = 1.0f / sqrtf(wave_sum(ss) * (1.0f / D) + EPS);
#pragma unroll
        for (int j = 0; j < 4; ++j) {
            const int col = 4 * lane + 256 * j;
            const f32x4 w = *(const f32x4*)(pre1 + col), sh = *(const f32x4*)(mv + col), sc = *(const f32x4*)(mv + 1024 + col);
            f32x4 h;
#pragma unroll
            for (int e = 0; e < 4; ++e) h[e] = v[j][e] * rstd * w[e] * (1.0f + sc[e]) + sh[e];
            u32x2 o; o.x = pk2(h[0], h[1]); o.y = pk2(h[2], h[3]);
            *(u32x2*)(h1 + (size_t)m * D + col) = o;
        }
    }
}

namespace pg8 {
#define PG8_LAS __attribute__((address_space(3)))
typedef unsigned short bf16_t;
typedef short bf16x8 __attribute__((ext_vector_type(8)));
typedef float f32x4 __attribute__((ext_vector_type(4)));
typedef unsigned u32x4 __attribute__((ext_vector_type(4)));
constexpr int BM = 256, BK = 64, HALF = 128, HTB = HALF * BK * 2  , STAGE_BYTES = 8 * HTB, NXCD = 8, WGM = 8;

__host__ __device__ __forceinline__ int lds_byte(int r, int c) { const int st = (r >> 4) * 2 + (c >> 5), rr = r & 15, cc = c & 31, ob = rr * 64 + cc * 2; return st * 1024 + (ob ^ (((ob >> 9) & 1) << 5)); }
__host__ __device__ __forceinline__ void stage_rc(int b, int& R, int& C) { const int st = b / 1024, sb = b % 1024, swz = sb ^ (((sb >> 9) & 1) << 5); R = (st >> 1) * 16 + swz / 64; C = (st & 1) * 32 + (swz % 64) / 2; }
__host__ __device__ __forceinline__ int perm32(int rho) { const int n = rho >> 4, i = rho & 15; return 8 * (i >> 2) + 4 * n + (i & 3); }

struct Unit { int pm, pn; };
struct Gemm { const bf16_t* A; const bf16_t* Bt; int M, N, K, lda; };

struct StaticOrder {
    int nM, nN, nwg, G, c;
    __host__ __device__ void init(int M, int N, int G_, int c_) { nM = M / BM; nN = N / BM; nwg = nM * nN; G = G_; c = c_; }
    __host__ __device__ bool next(int i, Unit& u) const {
        const long L = (long)i * G + c; if (L >= nwg) return false;
        int wgid = (int)L; { const int q = nwg / NXCD, r = nwg % NXCD, xcd = wgid % NXCD, off = wgid / NXCD; wgid = (xcd < r ? xcd * (q + 1) : r * (q + 1) + (xcd - r) * q) + off; }
        const int nig = WGM * nN, gid = wgid / nig, fm = gid * WGM, gsz = (nM - fm) < WGM ? (nM - fm) : WGM;
        u.pm = fm + ((wgid % nig) % gsz); u.pn = (wgid % nig) / gsz; return true;
    }
    __device__ __forceinline__ void a_ready(const Unit&) const {}
    __device__ __forceinline__ void done(const Unit&) const {}
};

__device__ __forceinline__ unsigned cvt_pk_bf16(float lo, float hi) { unsigned r; asm volatile("v_cvt_pk_bf16_f32 %0, %1, %2" : "=v"(r) : "v"(lo), "v"(hi)); return r; }
__device__ __forceinline__ float sigm(float x) { return __builtin_amdgcn_rcpf(1.0f + __expf(-x)); }
__device__ __forceinline__ float lo16(unsigned w) { return __builtin_bit_cast(float, w << 16); }
__device__ __forceinline__ float hi16(unsigned w) { return __builtin_bit_cast(float, w & 0xffff0000u); }

struct EpiStoreBf16 {
    static constexpr bool PERM = true, AFTER_DRAIN = false;
    bf16_t* O; int ldc;
    __device__ __forceinline__ void operator()(const f32x4 (&acc)[2][2][4][2], const Unit& u, int wr, int wc, int fr, int fq) const {
        const int row0 = u.pm * BM + wr * 64 + fr, col0 = u.pn * BM + wc * 32 + 8 * fq;
#pragma unroll
        for (int ai = 0; ai < 2; ++ai)
#pragma unroll
            for (int m = 0; m < 4; ++m) { bf16_t* rowp = O + (size_t)(row0 + ai * HALF + m * 16) * ldc + col0;
#pragma unroll
                for (int bj = 0; bj < 2; ++bj) { const f32x4 v0 = acc[ai][bj][m][0], v1 = acc[ai][bj][m][1];
                    u32x4 w; w.x = cvt_pk_bf16(v0[0], v0[1]); w.y = cvt_pk_bf16(v0[2], v0[3]); w.z = cvt_pk_bf16(v1[0], v1[1]); w.w = cvt_pk_bf16(v1[2], v1[3]);
                    *(u32x4*)(rowp + bj * HALF) = w; } }
    }
};
template <int SECOND> struct EpiBranch {
    static constexpr bool PERM = true, AFTER_DRAIN = false;
    bf16_t* T; int ldt; const bf16_t* G; int ldg; int gcol0;
    __device__ __forceinline__ void operator()(const f32x4 (&acc)[2][2][4][2], const Unit& u, int wr, int wc, int fr, int fq) const {
        const int row0 = u.pm * BM + wr * 64 + fr, col0 = u.pn * BM + wc * 32 + 8 * fq;
#pragma unroll
        for (int ai = 0; ai < 2; ++ai)
#pragma unroll
            for (int m = 0; m < 4; ++m) { const size_t row = (size_t)(row0 + ai * HALF + m * 16);
#pragma unroll
                for (int bj = 0; bj < 2; ++bj) { const f32x4 v0 = acc[ai][bj][m][0], v1 = acc[ai][bj][m][1];
                    const u32x4 g = *(const u32x4*)(G + row * ldg + gcol0 + col0 + bj * HALF);
                    float r[8] = {sigm(lo16(g.x)) * v0[0], sigm(hi16(g.x)) * v0[1], sigm(lo16(g.y)) * v0[2], sigm(hi16(g.y)) * v0[3],
                                  sigm(lo16(g.z)) * v1[0], sigm(hi16(g.z)) * v1[1], sigm(lo16(g.w)) * v1[2], sigm(hi16(g.w)) * v1[3]};
                    bf16_t* tp = T + row * ldt + col0 + bj * HALF;
                    if (SECOND) { const u32x4 t = *(const u32x4*)tp;
                        r[0] += lo16(t.x); r[1] += hi16(t.x); r[2] += lo16(t.y); r[3] += hi16(t.y); r[4] += lo16(t.z); r[5] += hi16(t.z); r[6] += lo16(t.w); r[7] += hi16(t.w); }
                    u32x4 w; w.x = cvt_pk_bf16(r[0], r[1]); w.y = cvt_pk_bf16(r[2], r[3]); w.z = cvt_pk_bf16(r[4], r[5]); w.w = cvt_pk_bf16(r[6], r[7]);
                    *(u32x4*)tp = w; } }
    }
};
struct EpiSwiGLU {
    static constexpr bool PERM = false, AFTER_DRAIN = false;
    bf16_t* ACT; int ldc;
    __device__ __forceinline__ void operator()(const f32x4 (&acc)[2][2][4][2], const Unit& u, int wr, int wc, int fr, int fq) const {
        const int row0 = u.pm * BM + wr * 64 + fr, ch0 = u.pn * HALF + wc * 16 + 4 * fq;
#pragma unroll
        for (int ai = 0; ai < 2; ++ai)
#pragma unroll
            for (int m = 0; m < 4; ++m) { bf16_t* rowp = ACT + (size_t)(row0 + ai * HALF + m * 16) * ldc + ch0;
#pragma unroll
                for (int bj = 0; bj < 2; ++bj) { const f32x4 g = acc[ai][bj][m][0], up = acc[ai][bj][m][1];
                    float r[4];
#pragma unroll
                    for (int e = 0; e < 4; ++e) r[e] = g[e] * sigm(g[e]) * up[e];
                    u32x2 w; w.x = cvt_pk_bf16(r[0], r[1]); w.y = cvt_pk_bf16(r[2], r[3]);
                    *(u32x2*)(rowp + bj * 64) = w; } }
    }
};

template <class Epi, class Sched, bool ALIGN_EPI = false, bool SP2 = false>
__device__ __forceinline__ void gemm_phase(PG8_LAS unsigned char* lds, const Gemm g, const Sched& S, const Epi& E) {
    const int tid = threadIdx.x, wid = __builtin_amdgcn_readfirstlane(tid >> 6), lane = tid & 63, wr = wid >> 2, wc = wid & 3, fr = lane & 15, fq = lane >> 4;
    const int K = g.K, nt = K / BK;
    unsigned voffA[2], voffB[2];
#pragma unroll
    for (int i = 0; i < 2; ++i) { int R, C; stage_rc(tid * 16 + i * 8192, R, C); const int Rb = Epi::PERM ? ((R & ~31) + perm32(R & 31)) : R;
        voffA[i] = (unsigned)(R * g.lda + C) * 2u; voffB[i] = (unsigned)(Rb * K + C) * 2u; }
    const size_t kstep = (size_t)(BK * 2);
    const size_t hstepA = (size_t)HALF * g.lda * 2, hstepB = (size_t)HALF * K * 2;
    const size_t tstepA = 2 * hstepA, tstepB = 2 * hstepB;
    const unsigned ldsw = (unsigned)wid * 1024u;
    const int aoff = lds_byte(wr * 64 + fr, fq * 8), boff = lds_byte(wc * 32 + fr, fq * 8);
#define PG8_SA(b, h) (((b) * 2 + (h)) * HTB)
#define PG8_SB(b, h) ((4 + (b) * 2 + (h)) * HTB)
#define PG8_STAGE(bufoff, gbase, voff) do { _Pragma("unroll") for (int _i = 0; _i < 2; ++_i) \
        __builtin_amdgcn_global_load_lds((const unsigned*)((const char*)(gbase) + (voff)[_i]), (PG8_LAS unsigned*)(lds + (bufoff) + ldsw + _i * 8192), 16, 0, 0); } while (0)
#define PG8_LDA(dst, b, h) do { _Pragma("unroll") for (int m = 0; m < 4; ++m) _Pragma("unroll") for (int k = 0; k < 2; ++k) dst[m][k] = *(const PG8_LAS bf16x8*)(lds + PG8_SA(b, h) + aoff + m * 2048 + k * 1024); } while (0)
#define PG8_LDB(dst, b, h) do { _Pragma("unroll") for (int n = 0; n < 2; ++n) _Pragma("unroll") for (int k = 0; k < 2; ++k) dst[n][k] = *(const PG8_LAS bf16x8*)(lds + PG8_SB(b, h) + boff + n * 2048 + k * 1024); } while (0)
#define PG8_MMA(ai, bj, At, Bt) do { __builtin_amdgcn_s_setprio(1); _Pragma("unroll") for (int m = 0; m < 4; ++m) _Pragma("unroll") for (int n = 0; n < 2; ++n) _Pragma("unroll") for (int k = 0; k < 2; ++k) \
        acc[ai][bj][m][n] = __builtin_amdgcn_mfma_f32_16x16x32_bf16(Bt[n][k], At[m][k], acc[ai][bj][m][n], 0, 0, 0); __builtin_amdgcn_s_setprio(0); } while (0)
#define PG8_WAIT_V(n) asm volatile("s_waitcnt vmcnt(" #n ")" ::: "memory")
#define PG8_WAIT_L(n) asm volatile("s_waitcnt lgkmcnt(" #n ")" ::: "memory")
#define PG8_BAR __builtin_amdgcn_s_barrier()
#define PG8_SCHED __builtin_amdgcn_sched_barrier(0)
    Unit cur, nxt; int ui = 0;
    if (!S.next(0, cur)) return;
    f32x4 acc[2][2][4][2];
#pragma unroll
    for (int a = 0; a < 2; ++a)
#pragma unroll
        for (int b = 0; b < 2; ++b)
#pragma unroll
            for (int m = 0; m < 4; ++m)
#pragma unroll
                for (int n = 0; n < 2; ++n) acc[a][b][m][n] = (f32x4){0.f, 0.f, 0.f, 0.f};
    bf16x8 At[4][2], B0[2][2], B1[2][2];
    const char* cA = (const char*)g.A + (size_t)cur.pm * tstepA; const char* cB = (const char*)g.Bt + (size_t)cur.pn * tstepB;
    S.a_ready(cur);
    if constexpr (SP2) {
        PG8_STAGE(PG8_SB(0, 0), cB, voffB); PG8_STAGE(PG8_SB(0, 1), cB + hstepB, voffB); PG8_STAGE(PG8_SA(0, 0), cA, voffA); PG8_STAGE(PG8_SA(0, 1), cA + hstepA, voffA);
        if (wr == 1) PG8_BAR;
        PG8_WAIT_V(2); PG8_BAR;
        PG8_STAGE(PG8_SB(1, 0), cB + kstep, voffB); PG8_STAGE(PG8_SA(1, 0), cA + kstep, voffA); PG8_STAGE(PG8_SB(1, 1), cB + hstepB + kstep, voffB);
        PG8_WAIT_V(6); PG8_BAR;
    } else {
        PG8_STAGE(PG8_SB(0, 0), cB, voffB); PG8_STAGE(PG8_SA(0, 0), cA, voffA); PG8_STAGE(PG8_SB(0, 1), cB + hstepB, voffB); PG8_STAGE(PG8_SA(0, 1), cA + hstepA, voffA);
        if (wr == 1) PG8_BAR;
        PG8_WAIT_V(4); PG8_BAR;
        PG8_STAGE(PG8_SB(1, 0), cB + kstep, voffB); PG8_STAGE(PG8_SA(1, 0), cA + kstep, voffA); PG8_STAGE(PG8_SB(1, 1), cB + hstepB + kstep, voffB);
        PG8_WAIT_V(6); PG8_BAR;
    }
    for (;;) {
        const bool has_next = S.next(ui + 1, nxt);
        const char* nA = has_next ? (const char*)g.A + (size_t)nxt.pm * tstepA : cA; const char* nB = has_next ? (const char*)g.Bt + (size_t)nxt.pn * tstepB : cB;
        for (int t = 0; t < nt; t += 2) {
            const bool last = (t == nt - 2);
            const char* a1 = cA + (size_t)(t + 1) * kstep;
            const char* a2 = last ? nA : cA + (size_t)(t + 2) * kstep; const char* b2 = last ? nB : cB + (size_t)(t + 2) * kstep;
            const char* a3 = a2 + kstep; const char* b3 = b2 + kstep;
            if (last && has_next) S.a_ready(nxt);
            if constexpr (SP2) {
            PG8_LDB(B0, 0, 0); PG8_LDB(B1, 0, 1); PG8_SCHED; PG8_LDA(At, 0, 0); PG8_STAGE(PG8_SA(1, 1), a1 + hstepA, voffA);
            PG8_WAIT_V(8); PG8_WAIT_L(0); PG8_BAR; PG8_MMA(0, 0, At, B0); PG8_MMA(0, 1, At, B1); PG8_BAR; PG8_SCHED;
            PG8_LDA(At, 0, 1); PG8_STAGE(PG8_SB(0, 0), b2, voffB); PG8_STAGE(PG8_SB(0, 1), b2 + hstepB, voffB); PG8_STAGE(PG8_SA(0, 0), a2, voffA);
            PG8_WAIT_V(8); PG8_WAIT_L(0); PG8_BAR; PG8_MMA(1, 0, At, B0); PG8_MMA(1, 1, At, B1); PG8_BAR; PG8_SCHED;
            PG8_LDB(B0, 1, 0); PG8_LDB(B1, 1, 1); PG8_SCHED; PG8_LDA(At, 1, 0); PG8_STAGE(PG8_SA(0, 1), a2 + hstepA, voffA);
            PG8_WAIT_V(8); PG8_WAIT_L(0); PG8_BAR; PG8_MMA(0, 0, At, B0); PG8_MMA(0, 1, At, B1); PG8_BAR; PG8_SCHED;
            PG8_LDA(At, 1, 1); PG8_STAGE(PG8_SB(1, 0), b3, voffB); PG8_STAGE(PG8_SB(1, 1), b3 + hstepB, voffB); PG8_STAGE(PG8_SA(1, 0), a3, voffA);
            PG8_WAIT_V(8); PG8_WAIT_L(0); PG8_BAR; PG8_MMA(1, 0, At, B0); PG8_MMA(1, 1, At, B1); PG8_BAR; PG8_SCHED;
            } else {
            PG8_LDB(B0, 0, 0); PG8_SCHED; PG8_LDA(At, 0, 0); PG8_STAGE(PG8_SA(1, 1), a1 + hstepA, voffA);
            PG8_WAIT_L(8); PG8_BAR; PG8_WAIT_L(0); PG8_MMA(0, 0, At, B0); PG8_BAR; PG8_SCHED;
            PG8_LDB(B1, 0, 1); PG8_STAGE(PG8_SB(0, 0), b2, voffB);
            PG8_BAR; PG8_WAIT_L(0); PG8_MMA(0, 1, At, B1); PG8_BAR;
            PG8_LDA(At, 0, 1); PG8_STAGE(PG8_SA(0, 0), a2, voffA);
            PG8_BAR; PG8_WAIT_L(0); PG8_MMA(1, 0, At, B0); PG8_BAR; PG8_SCHED;
            PG8_STAGE(PG8_SB(0, 1), b2 + hstepB, voffB);
            PG8_WAIT_V(6); PG8_BAR; PG8_MMA(1, 1, At, B1); PG8_BAR;
            PG8_LDB(B0, 1, 0); PG8_SCHED; PG8_LDA(At, 1, 0); PG8_STAGE(PG8_SA(0, 1), a2 + hstepA, voffA);
            PG8_WAIT_L(8); PG8_BAR; PG8_WAIT_L(0); PG8_MMA(0, 0, At, B0); PG8_BAR; PG8_SCHED;
            PG8_LDB(B1, 1, 1); PG8_STAGE(PG8_SB(1, 0), b3, voffB);
            PG8_BAR; PG8_WAIT_L(0); PG8_MMA(0, 1, At, B1); PG8_BAR;
            PG8_LDA(At, 1, 1); PG8_STAGE(PG8_SA(1, 0), a3, voffA);
            PG8_BAR; PG8_WAIT_L(0); PG8_MMA(1, 0, At, B0); PG8_BAR; PG8_SCHED;
            PG8_STAGE(PG8_SB(1, 1), b3 + hstepB, voffB);
            PG8_WAIT_V(6); PG8_BAR; PG8_MMA(1, 1, At, B1); PG8_BAR;
            }
        }
        if constexpr (ALIGN_EPI) { if (wr == 0) PG8_BAR; }
        if constexpr (!Epi::AFTER_DRAIN) { E(acc, cur, wr, wc, fr, fq); S.done(cur); }
        if (!has_next) break;
#pragma unroll
        for (int a = 0; a < 2; ++a)
#pragma unroll
            for (int b = 0; b < 2; ++b)
#pragma unroll
                for (int m = 0; m < 4; ++m)
#pragma unroll
                    for (int n = 0; n < 2; ++n) acc[a][b][m][n] = (f32x4){0.f, 0.f, 0.f, 0.f};
        cur = nxt; cA = nA; cB = nB; ++ui;
        if constexpr (ALIGN_EPI) { if (wr == 1) PG8_BAR; }
    }
    PG8_WAIT_V(0);
    if constexpr (!ALIGN_EPI) { if (wr == 0) PG8_BAR; }
    PG8_BAR;
    if constexpr (Epi::AFTER_DRAIN) { E.fused(acc, cur, wr, wc, fr, fq, lds, wid, lane); S.done(cur); }
#undef PG8_SA
#undef PG8_SB
#undef PG8_STAGE
#undef PG8_LDA
#undef PG8_LDB
#undef PG8_MMA
#undef PG8_WAIT_V
#undef PG8_WAIT_L
#undef PG8_BAR
#undef PG8_SCHED
}
}

constexpr int SC_QT = 0, SC_QH = 18432, SC_KT = 36864, SC_ST = 82944, SC_KH = 101376, SC_VT = 121856, SC_P = 132096, SC_LR = 142336, SC_TOT = 144384, SC_DEC = 146432;
static_assert(SC_DEC + 512 <= LDS_BYTES, "scan LDS map");
constexpr int RS128 = 288, RS64 = 160;

__device__ __forceinline__ int scan_chunk_base(int ci, int dir, int b) {
    if (ci < 4) { const int cc = dir ? 3 - ci : ci; return MLAT + b * CTXL + cc * 64; }
    const int lc = dir ? 35 - ci : ci - 4; return b * SEQ + lc * 64;
}

__device__ __forceinline__ void phase3(const Params& p, LAS unsigned char* lds) {
    const int tid = threadIdx.x, lane = tid & 63, wave = __builtin_amdgcn_readfirstlane(tid >> 6), fr = lane & 15, fq = lane >> 4;
    const int k = tid & 127, I = wave >> 1;
    const bf16* PA = (const bf16*)(p.ws + WS_PA);
    const float* lbv = (const float*)(p.ws + WS_LB);
    bf16* O = (bf16*)p.out;
    for (int it = blockIdx.x; it < 256; it += gridDim.x) {
        const int vh = it & 1, b = (it >> 1) & 7, hh = (it >> 4) & 3, dir = (it >> 6) & 1, br = it >> 7;
        const int qcol = (br ? 2048 : 0) + hh * 128;
        const int fcol = br ? 2560 + hh * 128 : 1024 + dir * 512 + hh * 128;
        const int vcol = (br ? 3072 : 512) + hh * 128 + vh * 64;
        const int lrcol = 3584 + dir * 16;
        for (int e = tid; e < 18432 / 16; e += NTHREADS) *(LAS u32x4*)(lds + SC_ST + e * 16) = (u32x4){0u, 0u, 0u, 0u};
        for (int e = tid; e < 10240 / 16; e += NTHREADS) *(LAS u32x4*)(lds + SC_P + e * 16) = (u32x4){0u, 0u, 0u, 0u};
        f32x4 S[4];
#pragma unroll
        for (int j = 0; j < 4; ++j) S[j] = (f32x4){0.f, 0.f, 0.f, 0.f};
        float lbk = 0.f, bgk = 0.f; float wg[16];
#pragma unroll
        for (int r = 0; r < 16; ++r) wg[r] = 0.f;
        if (br == 0) lbk = lbv[dir * 512 + hh * 128 + k];
        else { bgk = p.in[14][dir * 512 + hh * 128 + k];
#pragma unroll
            for (int r = 0; r < 16; ++r) wg[r] = p.in[13][(size_t)(dir * 16 + r) * 512 + hh * 128 + k]; }
        unsigned pqf[16]; u32x4 pv, plr = {0u, 0u, 0u, 0u};
#define SCAN_PREFETCH(ci_) do { const int base_ = scan_chunk_base((ci_), dir, b); \
            _Pragma("unroll") for (int j = 0; j < 16; ++j) { const int r_ = 16 * I + j; const bf16* pr_ = PA + (size_t)(base_ + (dir ? 63 - r_ : r_)) * NA; pqf[j] = (unsigned)pr_[qcol + k] | ((unsigned)pr_[fcol + k] << 16); } \
            { const int s_ = tid & 63; pv = *(const u32x4*)(PA + (size_t)(base_ + (dir ? 63 - s_ : s_)) * NA + vcol + (tid >> 6) * 8); } \
            if (br && tid < 128) { const int s_ = tid >> 1; plr = *(const u32x4*)(PA + (size_t)(base_ + (dir ? 63 - s_ : s_)) * NA + lrcol + 8 * (tid & 1)); } } while (0)
        SCAN_PREFETCH(0);
        __syncthreads();
#pragma unroll 1
        for (int ci = 0; ci < 36; ++ci) {
            int k_ = k, fr_ = fr, fq_ = fq; asm volatile("" : "+v"(k_), "+v"(fr_), "+v"(fq_));
            if (br && tid < 128) *(LAS u32x4*)(lds + SC_LR + tid * 16) = plr;
            __syncthreads();
            float cj[16], qv[16], kv[16];
            if (br == 0) {
#pragma unroll
                for (int j = 0; j < 16; ++j) {
                    const float fraw = bfhi(pqf[j]), qraw = bflo(pqf[j]);
                    const float f = lbk + (1.0f - lbk) * sigmoidf_(fraw);
                    cj[j] = __logf(f); kv[j] = 1.0f - f; qv[j] = qraw * sigmoidf_(qraw);
                }
            } else {
#pragma unroll
                for (int j = 0; j < 16; ++j) {
                    const LAS u32x4* lp = (const LAS u32x4*)(lds + SC_LR + (16 * I + j) * 32);
                    const u32x4 l0 = lp[0], l1 = lp[1];
                    float x = bgk;
                    x += bflo(l0.x) * wg[0] + bfhi(l0.x) * wg[1] + bflo(l0.y) * wg[2] + bfhi(l0.y) * wg[3];
                    x += bflo(l0.z) * wg[4] + bfhi(l0.z) * wg[5] + bflo(l0.w) * wg[6] + bfhi(l0.w) * wg[7];
                    x += bflo(l1.x) * wg[8] + bfhi(l1.x) * wg[9] + bflo(l1.y) * wg[10] + bfhi(l1.y) * wg[11];
                    x += bflo(l1.z) * wg[12] + bfhi(l1.z) * wg[13] + bflo(l1.w) * wg[14] + bfhi(l1.w) * wg[15];
                    const float ls = fminf(x, 0.f) - __logf(1.0f + __expf(-fabsf(x)));
                    cj[j] = ls * (1.0f / 16.0f); kv[j] = bfhi(pqf[j]); qv[j] = bflo(pqf[j]) * 0.08838834764831845f;
                }
            }
#pragma unroll
            for (int j = 1; j < 16; ++j) cj[j] += cj[j - 1];
            ((LAS float*)(lds + SC_TOT))[I * 128 + k_] = cj[15];
            {
                const int s_ = tid & 63, c8 = (tid >> 6) * 8;
                LAS bf16* vt = (LAS bf16*)(lds + SC_VT);
                const unsigned vw[4] = {pv.x, pv.y, pv.z, pv.w};
#pragma unroll
                for (int e = 0; e < 4; ++e) { vt[(c8 + 2 * e) * (RS64 / 2) + s_] = (bf16)(vw[e] & 0xffffu); vt[(c8 + 2 * e + 1) * (RS64 / 2) + s_] = (bf16)(vw[e] >> 16); }
            }
            __syncthreads();
            {
                const LAS float* tot = (const LAS float*)(lds + SC_TOT);
                const float t0 = tot[k_], t1 = tot[128 + k_], t2 = tot[256 + k_], t3 = tot[384 + k_];
                const float R1 = t0, R2 = t0 + t1, R3 = R2 + t2, R4 = R3 + t3;
                const float RI = I == 0 ? 0.f : (I == 1 ? R1 : (I == 2 ? R2 : R3));
                const float RN = I == 0 ? R1 : (I == 1 ? R2 : (I == 2 ? R3 : R4));
                const float eRI = __expf(RI);
                const float e1 = __expf(R1 - RN), e2 = __expf(R2 - RN), e3 = __expf(R3 - RN), e4 = __expf(R4 - RN);
                if (I == 3) ((LAS float*)(lds + SC_DEC))[k_] = __expf(R4);
                LAS bf16* qt = (LAS bf16*)(lds + SC_QT); LAS bf16* qh = (LAS bf16*)(lds + SC_QH); LAS bf16* kt = (LAS bf16*)(lds + SC_KT);
                unsigned khw[8];
#pragma unroll
                for (int j = 0; j < 16; ++j) {
                    const int r = 16 * I + j;
                    const float ec = __expf(cj[j]);
                    const float einv = __expf(fminf(-cj[j], 80.f));
                    const float g = __expf(cj[15] - cj[j]);
                    const float qtv = qv[j] * ec;
                    qt[r * (RS128 / 2) + k_] = (bf16)f2bf(qtv);
                    qh[r * (RS128 / 2) + k_] = (bf16)f2bf(qtv * eRI);
                    const float kg = kv[j] * g;
                    if (I == 0) { kt[(0 + r) * (RS128 / 2) + k_] = (bf16)f2bf(kv[j] * einv); kt[(16 + r) * (RS128 / 2) + k_] = (bf16)f2bf(kg); kt[(48 + r) * (RS128 / 2) + k_] = (bf16)f2bf(kg * e2); kt[(96 + r) * (RS128 / 2) + k_] = (bf16)f2bf(kg * e3); }
                    else if (I == 1) { kt[(16 + r) * (RS128 / 2) + k_] = (bf16)f2bf(kv[j] * einv); kt[(48 + r) * (RS128 / 2) + k_] = (bf16)f2bf(kg); kt[(96 + r) * (RS128 / 2) + k_] = (bf16)f2bf(kg * e3); }
                    else if (I == 2) { kt[(48 + r) * (RS128 / 2) + k_] = (bf16)f2bf(kv[j] * einv); kt[(96 + r) * (RS128 / 2) + k_] = (bf16)f2bf(kg); }
                    else { kt[(96 + r) * (RS128 / 2) + k_] = (bf16)f2bf(kv[j] * einv); }
                    const unsigned khv = f2bf(kg * e4);
                    if (j & 1) khw[j >> 1] |= khv << 16; else khw[j >> 1] = khv;
                }
                (void)e1;
                LAS u32x4* khp = (LAS u32x4*)(lds + SC_KH + k_ * RS64 + I * 32);
                khp[0] = (u32x4){khw[0], khw[1], khw[2], khw[3]}; khp[1] = (u32x4){khw[4], khw[5], khw[6], khw[7]};
            }
            if (ci + 1 < 36) SCAN_PREFETCH(ci + 1);
            __syncthreads();
            for (int ti = wave; ti < 10; ti += 8) {
                const int Ib = ti >= 6 ? 3 : (ti >= 3 ? 2 : (ti >= 1 ? 1 : 0)), Jb = ti - (Ib * (Ib + 1)) / 2, kbase = 8 * Ib * (Ib + 1);
                f32x4 acc = {0.f, 0.f, 0.f, 0.f};
#pragma unroll
                for (int ks = 0; ks < 4; ++ks) {
                    const bf16x8 a = *(const LAS bf16x8*)(lds + SC_QT + (16 * Ib + fr_) * RS128 + (32 * ks + 8 * fq_) * 2);
                    const bf16x8 bb = *(const LAS bf16x8*)(lds + SC_KT + (kbase + 16 * Jb + fr_) * RS128 + (32 * ks + 8 * fq_) * 2);
                    acc = __builtin_amdgcn_mfma_f32_16x16x32_bf16(a, bb, acc, 0, 0, 0);
                }
                LAS bf16* pp = (LAS bf16*)(lds + SC_P);
#pragma unroll
                for (int reg = 0; reg < 4; ++reg) {
                    const int t = 4 * fq_ + reg;
                    const float v = (Ib != Jb || fr_ <= t) ? acc[reg] : 0.f;
                    pp[(16 * Ib + t) * (RS64 / 2) + 16 * Jb + fr_] = (bf16)f2bf(v);
                }
            }
            const int I2 = wave >> 1, JcA = 2 * (wave & 1);
            f32x4 ao[2] = {{0.f, 0.f, 0.f, 0.f}, {0.f, 0.f, 0.f, 0.f}};
#pragma unroll
            for (int ks = 0; ks < 4; ++ks) {
                const bf16x8 a = *(const LAS bf16x8*)(lds + SC_QH + (16 * I2 + fr_) * RS128 + (32 * ks + 8 * fq_) * 2);
#pragma unroll
                for (int jj = 0; jj < 2; ++jj) {
                    const bf16x8 bb = *(const LAS bf16x8*)(lds + SC_ST + (16 * (JcA + jj) + fr_) * RS128 + (32 * ks + 8 * fq_) * 2);
                    ao[jj] = __builtin_amdgcn_mfma_f32_16x16x32_bf16(a, bb, ao[jj], 0, 0, 0);
                }
            }
            {
                const f32x4 dec = *(const LAS f32x4*)(lds + SC_DEC + (16 * wave + 4 * fq_) * 4);
#pragma unroll
                for (int jc = 0; jc < 4; ++jc) S[jc] = S[jc] * dec;
#pragma unroll
                for (int ks = 0; ks < 2; ++ks) {
                    const bf16x8 a = *(const LAS bf16x8*)(lds + SC_KH + (16 * wave + fr_) * RS64 + (32 * ks + 8 * fq_) * 2);
#pragma unroll
                    for (int jc = 0; jc < 4; ++jc) {
                        const bf16x8 bb = *(const LAS bf16x8*)(lds + SC_VT + (16 * jc + fr_) * RS64 + (32 * ks + 8 * fq_) * 2);
                        S[jc] = __builtin_amdgcn_mfma_f32_16x16x32_bf16(a, bb, S[jc], 0, 0, 0);
                    }
                }
            }
            __syncthreads();
            {
                const int nks = I2 < 2 ? 1 : 2;
                for (int ks = 0; ks < nks; ++ks) {
                    const bf16x8 a = *(const LAS bf16x8*)(lds + SC_P + (16 * I2 + fr_) * RS64 + (32 * ks + 8 * fq_) * 2);
#pragma unroll
                    for (int jj = 0; jj < 2; ++jj) {
                        const bf16x8 bb = *(const LAS bf16x8*)(lds + SC_VT + (16 * (JcA + jj) + fr_) * RS64 + (32 * ks + 8 * fq_) * 2);
                        ao[jj] = __builtin_amdgcn_mfma_f32_16x16x32_bf16(a, bb, ao[jj], 0, 0, 0);
                    }
                }
                if (ci >= 4) {
                    const int base = scan_chunk_base(ci, dir, b);
                    bf16* ob = O + (size_t)(br * 2 + dir) * MLAT * 512 + hh * 128 + vh * 64;
#pragma unroll
                    for (int reg = 0; reg < 4; ++reg) {
                        const int t = 16 * I2 + 4 * fq_ + reg; const size_t row = (size_t)(base + (dir ? 63 - t : t));
#pragma unroll
                        for (int jj = 0; jj < 2; ++jj) ob[row * 512 + 16 * (JcA + jj) + fr_] = (bf16)f2bf(ao[jj][reg]);
                    }
                }
#pragma unroll
                for (int jc = 0; jc < 4; ++jc) {
                    u32x2 w; w.x = pk2(S[jc][0], S[jc][1]); w.y = pk2(S[jc][2], S[jc][3]);
                    *(LAS u32x2*)(lds + SC_ST + (16 * jc + fr_) * RS128 + (16 * wave + 4 * fq_) * 2) = w;
                }
            }
            __syncthreads();
        }
#undef SCAN_PREFETCH
    }
}

__device__ __forceinline__ void phase5(const Params& p) {
    const int tid = threadIdx.x, lane = tid & 63, wave = tid >> 6;
    const int gw = blockIdx.x * NWAVES + wave, NGW = gridDim.x * NWAVES;
    const bf16* O = (const bf16*)p.out; const bf16* PB = (const bf16*)(p.ws + WS_PA); bf16* A12 = (bf16*)(p.ws + WS_A12);
    for (int m = gw; m < MLAT; m += NGW) {
#pragma unroll
        for (int hd = 0; hd < 8; ++hd) {
            const int br = hd >> 2, col = (hd & 3) * 128 + 2 * lane;
            const unsigned a = *(const unsigned*)(O + ((size_t)(br * 2 + 0) * MLAT + m) * 512 + col), bq = *(const unsigned*)(O + ((size_t)(br * 2 + 1) * MLAT + m) * 512 + col);
            const float o0 = bflo(a) + bflo(bq), o1 = bfhi(a) + bfhi(bq);
            const float rstd = 1.0f / sqrtf(wave_sum(o0 * o0 + o1 * o1) * (1.0f / 128.0f) + EPS);
            const unsigned g = *(const unsigned*)(PB + (size_t)m * NBB + br * 512 + col);
            const float* on = (br ? p.in[15] : p.in[12]) + 2 * lane;
            const float r0 = o0 * rstd * on[0] * siluf_(bflo(g)), r1 = o1 * rstd * on[1] * siluf_(bfhi(g));
            *(unsigned*)(A12 + (size_t)m * D + hd * 128 + 2 * lane) = pk2(r0, r1);
        }
    }
}

__device__ __forceinline__ void phase8(const Params& p) {
    const int tid = threadIdx.x, lane = tid & 63, wave = tid >> 6;
    const int gw = blockIdx.x * NWAVES + wave, NGW = gridDim.x * NWAVES;
    const float* x = p.in[0]; const float* post1 = p.in[7]; const float* pre2 = p.in[8];
    const float* modv = (const float*)(p.ws + WS_MODV); const bf16* y1 = (const bf16*)(p.ws + WS_Y1); bf16* h2 = (bf16*)(p.ws + WS_H1);
    for (int m = gw; m < MLAT; m += NGW) {
        const float* mv = modv + (size_t)(m / SEQ) * NMOD;
        f32x4 y[4], z[4]; float ss = 0.f;
#pragma unroll
        for (int j = 0; j < 4; ++j) {
            const u32x2 w = *(const u32x2*)(y1 + (size_t)m * D + 4 * lane + 256 * j);
            y[j] = (f32x4){bflo(w.x), bfhi(w.x), bflo(w.y), bfhi(w.y)};
            ss += (y[j][0] * y[j][0] + y[j][1] * y[j][1]) + (y[j][2] * y[j][2] + y[j][3] * y[j][3]);
        }
        const float rstd1 = 1.0f / sqrtf(wave_sum(ss) * (1.0f / D) + EPS);
        float s2 = 0.f;
#pragma unroll
        for (int j = 0; j < 4; ++j) {
            const int col = 4 * lane + 256 * j;
            const f32x4 xv = *(const f32x4*)(x + (size_t)m * D + col), w = *(const f32x4*)(post1 + col), g = *(const f32x4*)(mv + 2048 + col);
#pragma unroll
            for (int e = 0; e < 4; ++e) { z[j][e] = xv[e] + g[e] * (y[j][e] * rstd1 * w[e]); s2 += z[j][e] * z[j][e]; }
            *(f32x4*)(p.out + (size_t)m * D + col) = z[j];
        }
        const float rstdz = 1.0f / sqrtf(wave_sum(s2) * (1.0f / D) + EPS);
#pragma unroll
        for (int j = 0; j < 4; ++j) {
            const int col = 4 * lane + 256 * j;
            const f32x4 w = *(const f32x4*)(pre2 + col), sh = *(const f32x4*)(mv + 3072 + col), sc = *(const f32x4*)(mv + 4096 + col);
            f32x4 h;
#pragma unroll
            for (int e = 0; e < 4; ++e) h[e] = z[j][e] * rstdz * w[e] * (1.0f + sc[e]) + sh[e];
            u32x2 o; o.x = pk2(h[0], h[1]); o.y = pk2(h[2], h[3]);
            *(u32x2*)(h2 + (size_t)m * D + col) = o;
        }
    }
}

__device__ __forceinline__ void phase11(const Params& p) {
    const int tid = threadIdx.x, lane = tid & 63, wave = tid >> 6;
    const int gw = blockIdx.x * NWAVES + wave, NGW = gridDim.x * NWAVES;
    const float* post2 = p.in[9];
    const float* modv = (const float*)(p.ws + WS_MODV); const bf16* y2 = (const bf16*)(p.ws + WS_A12);
    for (int m = gw; m < MLAT; m += NGW) {
        const float* mv = modv + (size_t)(m / SEQ) * NMOD;
        f32x4 y[4]; float ss = 0.f;
#pragma unroll
        for (int j = 0; j < 4; ++j) {
            const u32x2 w = *(const u32x2*)(y2 + (size_t)m * D + 4 * lane + 256 * j);
            y[j] = (f32x4){bflo(w.x), bfhi(w.x), bflo(w.y), bfhi(w.y)};
            ss += (y[j][0] * y[j][0] + y[j][1] * y[j][1]) + (y[j][2] * y[j][2] + y[j][3] * y[j][3]);
        }
        const float rstd2 = 1.0f / sqrtf(wave_sum(ss) * (1.0f / D) + EPS);
#pragma unroll
        for (int j = 0; j < 4; ++j) {
            const int col = 4 * lane + 256 * j;
            const f32x4 w = *(const f32x4*)(post2 + col), g = *(const f32x4*)(mv + 5120 + col);
            f32x4 z = *(const f32x4*)(p.out + (size_t)m * D + col);
#pragma unroll
            for (int e = 0; e < 4; ++e) z[e] += g[e] * (y[j][e] * rstd2 * w[e]);
            *(f32x4*)(p.out + (size_t)m * D + col) = z;
        }
    }
}

__global__ void __launch_bounds__(NTHREADS, 2) fwd_kernel(Params p) {
    extern __shared__ __attribute__((aligned(16))) unsigned char lds_raw[];
    LAS unsigned char* lds = (LAS unsigned char*)lds_raw;
    cg::grid_group grid = cg::this_grid();
    unsigned char* ws = p.ws;
    const int lo = p.ph_lo, hi = p.ph_hi;
#ifndef PHASE_MASK
#define PHASE_MASK 0xFFF
#endif
#define IN(k) ((((PHASE_MASK) >> (k)) & 1) && lo <= (k) && (k) < hi)
#define SYNC(k) do { if (IN(k) && IN((k) + 1)) grid.sync(); } while (0)
    if (IN(0)) phase0(p, lds);
    SYNC(0);
    if (IN(1)) phase1(p);
    SYNC(1);
    if (IN(2)) { pg8::Gemm g{(const bf16*)(ws + WS_H1), (const bf16*)(ws + WS_WA), MALL, NA, D, D}; pg8::StaticOrder S; S.init(MALL, NA, (int)gridDim.x, (int)blockIdx.x);
        pg8::EpiStoreBf16 e{(bf16*)(ws + WS_PA), NA}; pg8::gemm_phase<pg8::EpiStoreBf16, pg8::StaticOrder, true, true>(lds, g, S, e); }
    SYNC(2);
    if (IN(3)) phase3(p, lds);
    SYNC(3);
    if (IN(4)) { pg8::Gemm g{(const bf16*)(ws + WS_H1), (const bf16*)(ws + WS_WB), MLAT, NBB, D, D}; pg8::StaticOrder S; S.init(MLAT, NBB, (int)gridDim.x, (int)blockIdx.x);
        pg8::EpiStoreBf16 e{(bf16*)(ws + WS_PA), NBB}; pg8::gemm_phase<pg8::EpiStoreBf16, pg8::StaticOrder, true, true>(lds, g, S, e); }
    SYNC(4);
    if (IN(5)) phase5(p);
    SYNC(5);
    if (IN(6)) {
        pg8::StaticOrder S; S.init(MLAT, D, (int)gridDim.x, (int)blockIdx.x);
        { pg8::Gemm g{(const bf16*)(ws + WS_A12), (const bf16*)(ws + WS_WBRH), MLAT, D, 512, D};
          pg8::EpiBranch<0> e{(bf16*)(ws + WS_H1), D, (const bf16*)(ws + WS_PA), NBB, 1024}; pg8::gemm_phase<pg8::EpiBranch<0>, pg8::StaticOrder, true, true>(lds, g, S, e); }
        { pg8::Gemm g{(const bf16*)(ws + WS_A12) + 512, (const bf16*)(ws + WS_WBRG), MLAT, D, 512, D};
          pg8::EpiBranch<1> e{(bf16*)(ws + WS_H1), D, (const bf16*)(ws + WS_PA), NBB, 2048}; pg8::gemm_phase<pg8::EpiBranch<1>, pg8::StaticOrder, true, true>(lds, g, S, e); }
    }
    SYNC(6);
    if (IN(7)) { pg8::Gemm g{(const bf16*)(ws + WS_H1), (const bf16*)(ws + WS_WOUT), MLAT, D, D, D}; pg8::StaticOrder S; S.init(MLAT, D, (int)gridDim.x, (int)blockIdx.x);
        pg8::EpiStoreBf16 e{(bf16*)(ws + WS_Y1), D}; pg8::gemm_phase<pg8::EpiStoreBf16, pg8::StaticOrder, true, true>(lds, g, S, e); }
    SYNC(7);
    if (IN(8)) phase8(p);
    SYNC(8);
    if (IN(9)) { pg8::Gemm g{(const bf16*)(ws + WS_H1), (const bf16*)(ws + WS_WGU), MLAT, NGU, D, D}; pg8::StaticOrder S; S.init(MLAT, NGU, (int)gridDim.x, (int)blockIdx.x);
        pg8::EpiSwiGLU e{(bf16*)(ws + WS_PA), DFF}; pg8::gemm_phase<pg8::EpiSwiGLU, pg8::StaticOrder, true, true>(lds, g, S, e); }
    SYNC(9);
    if (IN(10)) { pg8::Gemm g{(const bf16*)(ws + WS_PA), (const bf16*)(ws + WS_WD), MLAT, D, DFF, DFF}; pg8::StaticOrder S; S.init(MLAT, D, (int)gridDim.x, (int)blockIdx.x);
        pg8::EpiStoreBf16 e{(bf16*)(ws + WS_A12), D}; pg8::gemm_phase<pg8::EpiStoreBf16, pg8::StaticOrder, true, true>(lds, g, S, e); }
    SYNC(10);
    if (IN(11)) phase11(p);
#undef IN
#undef SYNC
}

extern "C" void kernel_launch(void* const* d_in, const int* in_sizes, int n_in, void* d_out, int out_size, void* d_ws, size_t ws_size, hipStream_t stream) {
    static int grid = 0;
    if (grid == 0) {
        if (n_in != 22 || out_size != MLAT * D || ws_size < WS_END) { fprintf(stderr, "kernel_launch: unexpected shapes (n_in %d out %d ws %zu)\n", n_in, out_size, ws_size); grid = -1; return; }
        int dev = 0, cus = 0, per_cu = 0;
        hipGetDevice(&dev);
        hipDeviceGetAttribute(&cus, hipDeviceAttributeMultiprocessorCount, dev);
        hipFuncSetAttribute((const void*)fwd_kernel, hipFuncAttributeMaxDynamicSharedMemorySize, LDS_BYTES);
        hipOccupancyMaxActiveBlocksPerMultiprocessor(&per_cu, (const void*)fwd_kernel, NTHREADS, LDS_BYTES);
        if (per_cu < 1) { fprintf(stderr, "kernel_launch: occupancy query says %d blocks/CU\n", per_cu); per_cu = 1; }
        grid = cus * 1;
        (void)hipGetLastError();
    }
    if (grid < 0) return;
    Params p{};
    for (int i = 0; i < 22; ++i) p.in[i] = (const float*)d_in[i];
    p.out = (float*)d_out; p.ws = (unsigned char*)d_ws; p.ph_lo = 0; p.ph_hi = 12;
    void* args[] = {&p};
    hipError_t e = hipLaunchCooperativeKernel((const void*)fwd_kernel, dim3(grid), dim3(NTHREADS), args, LDS_BYTES, stream);
    if (e != hipSuccess) fprintf(stderr, "cooperative launch failed: %s (grid %d)\n", hipGetErrorString(e), grid);
}
```

```cpp
#include <hip/hip_runtime.h>
#include <cstdio>
#include <cstdint>

typedef unsigned short bf16;
typedef short bf16x8 __attribute__((ext_vector_type(8)));
typedef float f32x4 __attribute__((ext_vector_type(4)));
typedef unsigned u32x4 __attribute__((ext_vector_type(4)));
typedef unsigned u32x2 __attribute__((ext_vector_type(2)));
#define LAS __attribute__((address_space(3)))

constexpr int NB = 8, SEQ = 2048, CTXL = 256, D = 1024, DFF = 2816;
constexpr int MLAT = NB * SEQ, MCTX = NB * CTXL, MALL = MLAT + MCTX;
constexpr int INW = 6688, NMOD = 6144;
constexpr int NA = 3840;
constexpr int NBB = 3072;
constexpr int NGU = 2 * DFF;
constexpr float EPS = 1e-6f;
constexpr int NWAVES = 8, NTHREADS = 512;
constexpr int LDS_BYTES = 147456;
constexpr int LDSCTL_OFF = 147200;

constexpr size_t MiB = 1u << 20;
constexpr size_t WS_CTL = 0, CTL_ZERO_BYTES = 65536;
constexpr size_t WS_MODV = 1 * MiB;
constexpr size_t WS_LB = WS_MODV + 512 * 1024;
constexpr size_t WS_WA = 2 * MiB;
constexpr size_t WS_WB = 10 * MiB;
constexpr size_t WS_WBRH = 16 * MiB;
constexpr size_t WS_WBRG = 17 * MiB;
constexpr size_t WS_WOUT = 18 * MiB;
constexpr size_t WS_WGU = 20 * MiB;
constexpr size_t WS_WD = 31 * MiB;
constexpr size_t WS_H1 = 37 * MiB;
constexpr size_t WS_PA = 73 * MiB;
constexpr size_t WS_A12 = 169 * MiB;
constexpr size_t WS_Y1 = 201 * MiB;
constexpr size_t WS_END = 233 * MiB;

struct Params {
    const float* in[22];
    float* out;
    unsigned char* ws;
    int ph_lo, ph_hi;
};

__device__ __forceinline__ unsigned f2bf(float f) { unsigned u = __builtin_bit_cast(unsigned, f); return (u + 0x7fffu + ((u >> 16) & 1u)) >> 16; }
__device__ __forceinline__ unsigned pk2(float lo, float hi) { return f2bf(lo) | (f2bf(hi) << 16); }
__device__ __forceinline__ float bf2f(unsigned b) { return __builtin_bit_cast(float, b << 16); }
__device__ __forceinline__ float bflo(unsigned w) { return __builtin_bit_cast(float, w << 16); }
__device__ __forceinline__ float bfhi(unsigned w) { return __builtin_bit_cast(float, w & 0xffff0000u); }
__device__ __forceinline__ float sigmoidf_(float x) { return 1.0f / (1.0f + __expf(-x)); }
__device__ __forceinline__ float siluf_(float x) { return x / (1.0f + __expf(-x)); }
__device__ __forceinline__ float wave_sum(float v) {
#pragma unroll
    for (int o = 1; o < 64; o <<= 1) v += __shfl_xor(v, o);
    return v;
}

__device__ __forceinline__ void transpose_item(const float* W, int ldw, int c0, int ncols, int Kdst, bf16* WT, int row0, int mode, LAS float* scr, int item, int lane) {
    const int nblk = ncols / 32, kb = item / nblk, nb = item % nblk, k0 = 64 * kb, n0 = 32 * nb;
#pragma unroll 8
    for (int i = 0; i < 32; ++i) { const int kk = 2 * i + (lane >> 5); scr[kk * 33 + (lane & 31)] = W[(size_t)(k0 + kk) * ldw + c0 + n0 + (lane & 31)]; }
    asm volatile("s_waitcnt lgkmcnt(0)" ::: "memory");
    const int c = lane & 7;
#pragma unroll
    for (int j = 0; j < 4; ++j) {
        const int n = (lane >> 3) + 8 * j; const LAS float* s = scr + (8 * c) * 33 + n;
        u32x4 o; o.x = pk2(s[0 * 33], s[1 * 33]); o.y = pk2(s[2 * 33], s[3 * 33]); o.z = pk2(s[4 * 33], s[5 * 33]); o.w = pk2(s[6 * 33], s[7 * 33]);
        const int nn = n0 + n;
        const int drow = mode == 0 ? row0 + nn : (2 * (nn & ~15) + (nn & 15) + (mode == 2 ? 16 : 0));
        *(u32x4*)(WT + (size_t)drow * Kdst + k0 + 8 * c) = o;
    }
    asm volatile("s_waitcnt lgkmcnt(0)" ::: "memory");
}

__device__ __forceinline__ void phase0(const Params& p, LAS unsigned char* lds) {
    const int tid = threadIdx.x, lane = tid & 63, wave = tid >> 6;
    unsigned char* ws = p.ws;
    {
        LAS float* sil = (LAS float*)lds;
        LAS float* red = (LAS float*)(lds + 49152);
        const float* cv = p.in[1]; const float* cc = p.in[3]; const float* wm = p.in[4]; const float* bm = p.in[5];
        float* modv = (float*)(ws + WS_MODV);
        for (int it = blockIdx.x; it < NMOD / 64; it += gridDim.x) {
            __syncthreads();
            for (int e = tid; e < 9 * 1024; e += NTHREADS) { const int r = e >> 10, k = e & 1023; const float v = r < 8 ? cv[r * 1024 + k] : cc[k]; sil[k * 12 + r] = siluf_(v); }
            __syncthreads();
            const int j = it * 64 + lane;
            float acc[9];
#pragma unroll
            for (int r = 0; r < 9; ++r) acc[r] = 0.f;
            const int kbeg = wave * 128;
#pragma unroll 4
            for (int k = kbeg; k < kbeg + 128; ++k) {
                const float w = wm[(size_t)k * NMOD + j];
                const f32x4 s0 = *(const LAS f32x4*)(sil + k * 12), s1 = *(const LAS f32x4*)(sil + k * 12 + 4); const float s8 = sil[k * 12 + 8];
                acc[0] += s0[0] * w; acc[1] += s0[1] * w; acc[2] += s0[2] * w; acc[3] += s0[3] * w;
                acc[4] += s1[0] * w; acc[5] += s1[1] * w; acc[6] += s1[2] * w; acc[7] += s1[3] * w; acc[8] += s8 * w;
            }
#pragma unroll
            for (int r = 0; r < 9; ++r) red[(wave * 9 + r) * 64 + lane] = acc[r];
            __syncthreads();
            for (int e = tid; e < 9 * 64; e += NTHREADS) {
                const int r = e >> 6, l = e & 63; float s = 0.f;
#pragma unroll
                for (int w2 = 0; w2 < 8; ++w2) s += red[(w2 * 9 + r) * 64 + l];
                modv[(size_t)r * NMOD + it * 64 + l] = s + bm[it * 64 + l];
            }
        }
        __syncthreads();
    }
    {
        const int gt = blockIdx.x * NTHREADS + tid, GT = gridDim.x * NTHREADS;
        const float* hl = p.in[11]; float* lb = (float*)(ws + WS_LB);
        for (int e = gt; e < 1024; e += GT) lb[e] = sigmoidf_(hl[e] - hl[1024 + e]);
        u32x4* padp = (u32x4*)(ws + WS_WA + (size_t)3616 * 1024 * 2); const u32x4 z = {0u, 0u, 0u, 0u};
        for (int e = gt; e < 224 * 1024 * 2 / 16; e += GT) padp[e] = z;
    }
    {
        LAS float* scr = (LAS float*)(lds + wave * 8448);
        const int gw = blockIdx.x * NWAVES + wave, NGW = gridDim.x * NWAVES;
        const float* w_in = p.in[10];
        bf16* WA = (bf16*)(ws + WS_WA); bf16* WB = (bf16*)(ws + WS_WB);
        constexpr int I1 = 16 * 64, I2 = 16 * 48, I3 = 16 * 1, I4 = 16 * 16, I5 = 16 * 16, I6 = 16 * 64, I7 = 8 * 32, I8 = 8 * 32, I9 = 16 * 32, I10 = 16 * 88, I11 = 16 * 88, I12 = 44 * 32;
        constexpr int NIT = I1 + I2 + I3 + I4 + I5 + I6 + I7 + I8 + I9 + I10 + I11 + I12;
        for (int it = gw; it < NIT; it += NGW) {
            int r = it;
            if (r < I1) { transpose_item(w_in, INW, 0, 2048, 1024, WA, 0, 0, scr, r, lane); continue; } r -= I1;
            if (r < I2) { transpose_item(w_in, INW, 2560, 1536, 1024, WA, 2048, 0, scr, r, lane); continue; } r -= I2;
            if (r < I3) { transpose_item(w_in, INW, 4608, 32, 1024, WA, 3584, 0, scr, r, lane); continue; } r -= I3;
            if (r < I4) { transpose_item(w_in, INW, 2048, 512, 1024, WB, 0, 0, scr, r, lane); continue; } r -= I4;
            if (r < I5) { transpose_item(w_in, INW, 4096, 512, 1024, WB, 512, 0, scr, r, lane); continue; } r -= I5;
            if (r < I6) { transpose_item(w_in, INW, 4640, 2048, 1024, WB, 1024, 0, scr, r, lane); continue; } r -= I6;
            if (r < I7) { transpose_item(p.in[16], 1024, 0, 1024, 512, (bf16*)(ws + WS_WBRH), 0, 0, scr, r, lane); continue; } r -= I7;
            if (r < I8) { transpose_item(p.in[17], 1024, 0, 1024, 512, (bf16*)(ws + WS_WBRG), 0, 0, scr, r, lane); continue; } r -= I8;
            if (r < I9) { transpose_item(p.in[18], 1024, 0, 1024, 1024, (bf16*)(ws + WS_WOUT), 0, 0, scr, r, lane); continue; } r -= I9;
            if (r < I10) { transpose_item(p.in[19], DFF, 0, DFF, 1024, (bf16*)(ws + WS_WGU), 0, 1, scr, r, lane); continue; } r -= I10;
            if (r < I11) { transpose_item(p.in[20], DFF, 0, DFF, 1024, (bf16*)(ws + WS_WGU), 0, 2, scr, r, lane); continue; } r -= I11;
            transpose_item(p.in[21], 1024, 0, 1024, DFF, (bf16*)(ws + WS_WD), 0, 0, scr, r, lane);
        }
    }
}

__device__ __forceinline__ void phase1(const Params& p) {
    const int tid = threadIdx.x, lane = tid & 63, wave = tid >> 6;
    const int gw = blockIdx.x * NWAVES + wave, NGW = gridDim.x * NWAVES;
    const float* x = p.in[0]; const float* ctx = p.in[2]; const float* pre1 = p.in[6];
    const float* modv = (const float*)(p.ws + WS_MODV); bf16* h1 = (bf16*)(p.ws + WS_H1);
    for (int m = gw; m < MALL; m += NGW) {
        const float* src = m < MLAT ? x + (size_t)m * D : ctx + (size_t)(m - MLAT) * D;
        const float* mv = modv + (size_t)(m < MLAT ? m / SEQ : 8) * NMOD;
        f32x4 v[4]; float ss = 0.f;
#pragma unroll
        for (int j = 0; j < 4; ++j) { v[j] = ((const f32x4*)src)[lane + 64 * j]; ss += (v[j][0] * v[j][0] + v[j][1] * v[j][1]) + (v[j][2] * v[j][2] + v[j][3] * v[j][3]); }
        const float rstd = 1.0f / sqrtf(wave_sum(ss) * (1.0f / D) + EPS);
#pragma unroll
        for (int j = 0; j < 4; ++j) {
            const int col = 4 * lane + 256 * j;
            const f32x4 w = *(const f32x4*)(pre1 + col), sh = *(const f32x4*)(mv + col), sc = *(const f32x4*)(mv + 1024 + col);
            f32x4 h;
#pragma unroll
            for (int e = 0; e < 4; ++e) h[e] = v[j][e] * rstd * w[e] * (1.0f + sc[e]) + sh[e];
            u32x2 o; o.x = pk2(h[0], h[1]); o.y = pk2(h[2], h[3]);
            *(u32x2*)(h1 + (size_t)m * D + col) = o;
        }
    }
}

namespace pg8 {
#define PG8_LAS __attribute__((address_space(3)))
typedef unsigned short bf16_t;
typedef short bf16x8 __attribute__((ext_vector_type(8)));
typedef float f32x4 __attribute__((ext_vector_type(4)));
typedef unsigned u32x4 __attribute__((ext_vector_type(4)));
constexpr int BM = 256, BK = 64, HALF = 128, HTB = HALF * BK * 2  , STAGE_BYTES = 8 * HTB, NXCD = 8, WGM = 8;

__host__ __device__ __forceinline__ int lds_byte(int r, int c) { const int st = (r >> 4) * 2 + (c >> 5), rr = r & 15, cc = c & 31, ob = rr * 64 + cc * 2; return st * 1024 + (ob ^ (((ob >> 9) & 1) << 5)); }
__host__ __device__ __forceinline__ void stage_rc(int b, int& R, int& C) { const int st = b / 1024, sb = b % 1024, swz = sb ^ (((sb >> 9) & 1) << 5); R = (st >> 1) * 16 + swz / 64; C = (st & 1) * 32 + (swz % 64) / 2; }
__host__ __device__ __forceinline__ int perm32(int rho) { const int n = rho >> 4, i = rho & 15; return 8 * (i >> 2) + 4 * n + (i & 3); }

struct Unit { int pm, pn; };
struct Gemm { const bf16_t* A; const bf16_t* Bt; int M, N, K, lda; };

struct StaticOrder {
    int nM, nN, nwg, G, c;
    __host__ __device__ void init(int M, int N, int G_, int c_) { nM = M / BM; nN = N / BM; nwg = nM * nN; G = G_; c = c_; }
    __host__ __device__ bool next(int i, Unit& u) const {
        const long L = (long)i * G + c; if (L >= nwg) return false;
        int wgid = (int)L; { const int q = nwg / NXCD, r = nwg % NXCD, xcd = wgid % NXCD, off = wgid / NXCD; wgid = (xcd < r ? xcd * (q + 1) : r * (q + 1) + (xcd - r) * q) + off; }
        const int nig = WGM * nN, gid = wgid / nig, fm = gid * WGM, gsz = (nM - fm) < WGM ? (nM - fm) : WGM;
        u.pm = fm + ((wgid % nig) % gsz); u.pn = (wgid % nig) / gsz; return true;
    }
    __device__ __forceinline__ void a_ready(const Unit&) const {}
    __device__ __forceinline__ void done(const Unit&) const {}
};

__device__ __forceinline__ unsigned cvt_pk_bf16(float lo, float hi) { unsigned r; asm volatile("v_cvt_pk_bf16_f32 %0, %1, %2" : "=v"(r) : "v"(lo), "v"(hi)); return r; }
__device__ __forceinline__ float sigm(float x) { return __builtin_amdgcn_rcpf(1.0f + __expf(-x)); }
__device__ __forceinline__ float lo16(unsigned w) { return __builtin_bit_cast(float, w << 16); }
__device__ __forceinline__ float hi16(unsigned w) { return __builtin_bit_cast(float, w & 0xffff0000u); }

struct EpiStoreBf16 {
    static constexpr bool PERM = true, AFTER_DRAIN = false;
    bf16_t* O; int ldc;
    __device__ __forceinline__ void operator()(const f32x4 (&acc)[2][2][4][2], const Unit& u, int wr, int wc, int fr, int fq) const {
        const int row0 = u.pm * BM + wr * 64 + fr, col0 = u.pn * BM + wc * 32 + 8 * fq;
#pragma unroll
        for (int ai = 0; ai < 2; ++ai)
#pragma unroll
            for (int m = 0; m < 4; ++m) { bf16_t* rowp = O + (size_t)(row0 + ai * HALF + m * 16) * ldc + col0;
#pragma unroll
                for (int bj = 0; bj < 2; ++bj) { const f32x4 v0 = acc[ai][bj][m][0], v1 = acc[ai][bj][m][1];
                    u32x4 w; w.x = cvt_pk_bf16(v0[0], v0[1]); w.y = cvt_pk_bf16(v0[2], v0[3]); w.z = cvt_pk_bf16(v1[0], v1[1]); w.w = cvt_pk_bf16(v1[2], v1[3]);
                    *(u32x4*)(rowp + bj * HALF) = w; } }
    }
};
template <int SECOND> struct EpiBranch {
    static constexpr bool PERM = true, AFTER_DRAIN = false;
    bf16_t* T; int ldt; const bf16_t* G; int ldg; int gcol0;
    __device__ __forceinline__ void operator()(const f32x4 (&acc)[2][2][4][2], const Unit& u, int wr, int wc, int fr, int fq) const {
        const int row0 = u.pm * BM + wr * 64 + fr, col0 = u.pn * BM + wc * 32 + 8 * fq;
#pragma unroll
        for (int ai = 0; ai < 2; ++ai)
#pragma unroll
            for (int m = 0; m < 4; ++m) { const size_t row = (size_t)(row0 + ai * HALF + m * 16);
#pragma unroll
                for (int bj = 0; bj < 2; ++bj) { const f32x4 v0 = acc[ai][bj][m][0], v1 = acc[ai][bj][m][1];
                    const u32x4 g = *(const u32x4*)(G + row * ldg + gcol0 + col0 + bj * HALF);
                    float r[8] = {sigm(lo16(g.x)) * v0[0], sigm(hi16(g.x)) * v0[1], sigm(lo16(g.y)) * v0[2], sigm(hi16(g.y)) * v0[3],
                                  sigm(lo16(g.z)) * v1[0], sigm(hi16(g.z)) * v1[1], sigm(lo16(g.w)) * v1[2], sigm(hi16(g.w)) * v1[3]};
                    bf16_t* tp = T + row * ldt + col0 + bj * HALF;
                    if (SECOND) { const u32x4 t = *(const u32x4*)tp;
                        r[0] += lo16(t.x); r[1] += hi16(t.x); r[2] += lo16(t.y); r[3] += hi16(t.y); r[4] += lo16(t.z); r[5] += hi16(t.z); r[6] += lo16(t.w); r[7] += hi16(t.w); }
                    u32x4 w; w.x = cvt_pk_bf16(r[0], r[1]); w.y = cvt_pk_bf16(r[2], r[3]); w.z = cvt_pk_bf16(r[4], r[5]); w.w = cvt_pk_bf16(r[6], r[7]);
                    *(u32x4*)tp = w; } }
    }
};
struct EpiSwiGLU {
    static constexpr bool PERM = false, AFTER_DRAIN = false;
    bf16_t* ACT; int ldc;
    __device__ __forceinline__ void operator()(const f32x4 (&acc)[2][2][4][2], const Unit& u, int wr, int wc, int fr, int fq) const {
        const int row0 = u.pm * BM + wr * 64 + fr, ch0 = u.pn * HALF + wc * 16 + 4 * fq;
#pragma unroll
        for (int ai = 0; ai < 2; ++ai)
#pragma unroll
            for (int m = 0; m < 4; ++m) { bf16_t* rowp = ACT + (size_t)(row0 + ai * HALF + m * 16) * ldc + ch0;
#pragma unroll
                for (int bj = 0; bj < 2; ++bj) { const f32x4 g = acc[ai][bj][m][0], up = acc[ai][bj][m][1];
                    float r[4];
#pragma unroll
                    for (int e = 0; e < 4; ++e) r[e] = g[e] * sigm(g[e]) * up[e];
                    u32x2 w; w.x = cvt_pk_bf16(r[0], r[1]); w.y = cvt_pk_bf16(r[2], r[3]);
                    *(u32x2*)(rowp + bj * 64) = w; } }
    }
};

template <class Epi, class Sched, bool ALIGN_EPI = false, bool SP2 = false>
__device__ __forceinline__ void gemm_phase(PG8_LAS unsigned char* lds, const Gemm g, const Sched& S, const Epi& E) {
    const int tid = threadIdx.x, wid = __builtin_amdgcn_readfirstlane(tid >> 6), lane = tid & 63, wr = wid >> 2, wc = wid & 3, fr = lane & 15, fq = lane >> 4;
    const int K = g.K, nt = K / BK;
    unsigned voffA[2], voffB[2];
#pragma unroll
    for (int i = 0; i < 2; ++i) { int R, C; stage_rc(tid * 16 + i * 8192, R, C); const int Rb = Epi::PERM ? ((R & ~31) + perm32(R & 31)) : R;
        voffA[i] = (unsigned)(R * g.lda + C) * 2u; voffB[i] = (unsigned)(Rb * K + C) * 2u; }
    const size_t kstep = (size_t)(BK * 2);
    const size_t hstepA = (size_t)HALF * g.lda * 2, hstepB = (size_t)HALF * K * 2;
    const size_t tstepA = 2 * hstepA, tstepB = 2 * hstepB;
    const unsigned ldsw = (unsigned)wid * 1024u;
    const int aoff = lds_byte(wr * 64 + fr, fq * 8), boff = lds_byte(wc * 32 + fr, fq * 8);
#define PG8_SA(b, h) (((b) * 2 + (h)) * HTB)
#define PG8_SB(b, h) ((4 + (b) * 2 + (h)) * HTB)
#define PG8_STAGE(bufoff, gbase, voff) do { _Pragma("unroll") for (int _i = 0; _i < 2; ++_i) \
        __builtin_amdgcn_global_load_lds((const unsigned*)((const char*)(gbase) + (voff)[_i]), (PG8_LAS unsigned*)(lds + (bufoff) + ldsw + _i * 8192), 16, 0, 0); } while (0)
#define PG8_LDA(dst, b, h) do { _Pragma("unroll") for (int m = 0; m < 4; ++m) _Pragma("unroll") for (int k = 0; k < 2; ++k) dst[m][k] = *(const PG8_LAS bf16x8*)(lds + PG8_SA(b, h) + aoff + m * 2048 + k * 1024); } while (0)
#define PG8_LDB(dst, b, h) do { _Pragma("unroll") for (int n = 0; n < 2; ++n) _Pragma("unroll") for (int k = 0; k < 2; ++k) dst[n][k] = *(const PG8_LAS bf16x8*)(lds + PG8_SB(b, h) + boff + n * 2048 + k * 1024); } while (0)
#define PG8_MMA(ai, bj, At, Bt) do { __builtin_amdgcn_s_setprio(1); _Pragma("unroll") for (int m = 0; m < 4; ++m) _Pragma("unroll") for (int n = 0; n < 2; ++n) _Pragma("unroll") for (int k = 0; k < 2; ++k) \
        acc[ai][bj][m][n] = __builtin_amdgcn_mfma_f32_16x16x32_bf16(Bt[n][k], At[m][k], acc[ai][bj][m][n], 0, 0, 0); __builtin_amdgcn_s_setprio(0); } while (0)
#define PG8_WAIT_V(n) asm volatile("s_waitcnt vmcnt(" #n ")" ::: "memory")
#define PG8_WAIT_L(n) asm volatile("s_waitcnt lgkmcnt(" #n ")" ::: "memory")
#define PG8_BAR __builtin_amdgcn_s_barrier()
#define PG8_SCHED __builtin_amdgcn_sched_barrier(0)
    Unit cur, nxt; int ui = 0;
    if (!S.next(0, cur)) return;
    f32x4 acc[2][2][4][2];
#pragma unroll
    for (int a = 0; a < 2; ++a)
#pragma unroll
        for (int b = 0; b < 2; ++b)
#pragma unroll
            for (int m = 0; m < 4; ++m)
#pragma unroll
                for (int n = 0; n < 2; ++n) acc[a][b][m][n] = (f32x4){0.f, 0.f, 0.f, 0.f};
    bf16x8 At[4][2], B0[2][2], B1[2][2];
    const char* cA = (const char*)g.A + (size_t)cur.pm * tstepA; const char* cB = (const char*)g.Bt + (size_t)cur.pn * tstepB;
    S.a_ready(cur);
    if constexpr (SP2) {
        PG8_STAGE(PG8_SB(0, 0), cB, voffB); PG8_STAGE(PG8_SB(0, 1), cB + hstepB, voffB); PG8_STAGE(PG8_SA(0, 0), cA, voffA); PG8_STAGE(PG8_SA(0, 1), cA + hstepA, voffA);
        if (wr == 1) PG8_BAR;
        PG8_WAIT_V(2); PG8_BAR;
        PG8_STAGE(PG8_SB(1, 0), cB + kstep, voffB); PG8_STAGE(PG8_SA(1, 0), cA + kstep, voffA); PG8_STAGE(PG8_SB(1, 1), cB + hstepB + kstep, voffB);
        PG8_WAIT_V(6); PG8_BAR;
    } else {
        PG8_STAGE(PG8_SB(0, 0), cB, voffB); PG8_STAGE(PG8_SA(0, 0), cA, voffA); PG8_STAGE(PG8_SB(0, 1), cB + hstepB, voffB); PG8_STAGE(PG8_SA(0, 1), cA + hstepA, voffA);
        if (wr == 1) PG8_BAR;
        PG8_WAIT_V(4); PG8_BAR;
        PG8_STAGE(PG8_SB(1, 0), cB + kstep, voffB); PG8_STAGE(PG8_SA(1, 0), cA + kstep, voffA); PG8_STAGE(PG8_SB(1, 1), cB + hstepB + kstep, voffB);
        PG8_WAIT_V(6); PG8_BAR;
    }
    for (;;) {
        const bool has_next = S.next(ui + 1, nxt);
        const char* nA = has_next ? (const char*)g.A + (size_t)nxt.pm * tstepA : cA; const char* nB = has_next ? (const char*)g.Bt + (size_t)nxt.pn * tstepB : cB;
        for (int t = 0; t < nt; t += 2) {
            const bool last = (t == nt - 2);
            const char* a1 = cA + (size_t)(t + 1) * kstep;
            const char* a2 = last ? nA : cA + (size_t)(t + 2) * kstep; const char* b2 = last ? nB : cB + (size_t)(t + 2) * kstep;
            const char* a3 = a2 + kstep; const char* b3 = b2 + kstep;
            if (last && has_next) S.a_ready(nxt);
            if constexpr (SP2) {
            PG8_LDB(B0, 0, 0); PG8_LDB(B1, 0, 1); PG8_SCHED; PG8_LDA(At, 0, 0); PG8_STAGE(PG8_SA(1, 1), a1 + hstepA, voffA);
            PG8_WAIT_V(8); PG8_WAIT_L(0); PG8_BAR; PG8_MMA(0, 0, At, B0); PG8_MMA(0, 1, At, B1); PG8_BAR; PG8_SCHED;
            PG8_LDA(At, 0, 1); PG8_STAGE(PG8_SB(0, 0), b2, voffB); PG8_STAGE(PG8_SB(0, 1), b2 + hstepB, voffB); PG8_STAGE(PG8_SA(0, 0), a2, voffA);
            PG8_WAIT_V(8); PG8_WAIT_L(0); PG8_BAR; PG8_MMA(1, 0, At, B0); PG8_MMA(1, 1, At, B1); PG8_BAR; PG8_SCHED;
            PG8_LDB(B0, 1, 0); PG8_LDB(B1, 1, 1); PG8_SCHED; PG8_LDA(At, 1, 0); PG8_STAGE(PG8_SA(0, 1), a2 + hstepA, voffA);
            PG8_WAIT_V(8); PG8_WAIT_L(0); PG8_BAR; PG8_MMA(0, 0, At, B0); PG8_MMA(0, 1, At, B1); PG8_BAR; PG8_SCHED;
            PG8_LDA(At, 1, 1); PG8_STAGE(PG8_SB(1, 0), b3, voffB); PG8_STAGE(PG8_SB(1, 1), b3 + hstepB, voffB); PG8_STAGE(PG8_SA(1, 0), a3, voffA);
            PG8_WAIT_V(8); PG8_WAIT_L(0); PG8_BAR; PG8_MMA(1, 0, At, B0); PG8_MMA(1, 1, At, B1); PG8_BAR; PG8_SCHED;
            } else {
            PG8_LDB(B0, 0, 0); PG8_SCHED; PG8_LDA(At, 0, 0); PG8_STAGE(PG8_SA(1, 1), a1 + hstepA, voffA);
            PG8_WAIT_L(8); PG8_BAR; PG8_WAIT_L(0); PG8_MMA(0, 0, At, B0); PG8_BAR; PG8_SCHED;
            PG8_LDB(B1, 0, 1); PG8_STAGE(PG8_SB(0, 0), b2, voffB);
            PG8_BAR; PG8_WAIT_L(0); PG8_MMA(0, 1, At, B1); PG8_BAR;
            PG8_LDA(At, 0, 1); PG8_STAGE(PG8_SA(0, 0), a2, voffA);
            PG8_BAR; PG8_WAIT_L(0); PG8_MMA(1, 0, At, B0); PG8_BAR; PG8_SCHED;
            PG8_STAGE(PG8_SB(0, 1), b2 + hstepB, voffB);
            PG8_WAIT_V(6); PG8_BAR; PG8_MMA(1, 1, At, B1); PG8_BAR;
            PG8_LDB(B0, 1, 0); PG8_SCHED; PG8_LDA(At, 1, 0); PG8_STAGE(PG8_SA(0, 1), a2 + hstepA, voffA);
            PG8_WAIT_L(8); PG8_BAR; PG8_WAIT_L(0); PG8_MMA(0, 0, At, B0); PG8_BAR; PG8_SCHED;
            PG8_LDB(B1, 1, 1); PG8_STAGE(PG8_SB(1, 0), b3, voffB);
            PG8_BAR; PG8_WAIT_L(0); PG8_MMA(0, 1, At, B1); PG8_BAR;
            PG8_LDA(At, 1, 1); PG8_STAGE(PG8_SA(1, 0), a3, voffA);
            PG8_BAR; PG8_WAIT_L(0); PG8_MMA(1, 0, At, B0); PG8_BAR; PG8_SCHED;
            PG8_STAGE(PG8_SB(1, 1), b3 + hstepB, voffB);
            PG8_WAIT_V(6); PG8_BAR; PG8_MMA(1, 1, At, B1); PG8_BAR;
            }
        }
        if constexpr (ALIGN_EPI) { if (wr == 0) PG8_BAR; }
        if constexpr (!Epi::AFTER_DRAIN) { E(acc, cur, wr, wc, fr, fq); S.done(cur); }
        if (!has_next) break;
#pragma unroll
        for (int a = 0; a < 2; ++a)
#pragma unroll
            for (int b = 0; b < 2; ++b)
#pragma unroll
                for (int m = 0; m < 4; ++m)
#pragma unroll
                    for (int n = 0; n < 2; ++n) acc[a][b][m][n] = (f32x4){0.f, 0.f, 0.f, 0.f};
        cur = nxt; cA = nA; cB = nB; ++ui;
        if constexpr (ALIGN_EPI) { if (wr == 1) PG8_BAR; }
    }
    PG8_WAIT_V(0);
    if constexpr (!ALIGN_EPI) { if (wr == 0) PG8_BAR; }
    PG8_BAR;
    if constexpr (Epi::AFTER_DRAIN) { E.fused(acc, cur, wr, wc, fr, fq, lds, wid, lane); S.done(cur); }
#undef PG8_SA
#undef PG8_SB
#undef PG8_STAGE
#undef PG8_LDA
#undef PG8_LDB
#undef PG8_MMA
#undef PG8_WAIT_V
#undef PG8_WAIT_L
#undef PG8_BAR
#undef PG8_SCHED
}
}

constexpr int SC_QT = 0, SC_QH = 18432, SC_KT = 36864, SC_ST = 82944, SC_KH = 101376, SC_VT = 121856, SC_P = 132096, SC_LR = 142336, SC_TOT = 144384, SC_DEC = 146432;
static_assert(SC_DEC + 512 <= LDSCTL_OFF, "scan LDS map");
constexpr int RS128 = 288, RS64 = 160;

__device__ __forceinline__ int scan_chunk_base(int ci, int dir, int b) {
    if (ci < 4) { const int cc = dir ? 3 - ci : ci; return MLAT + b * CTXL + cc * 64; }
    const int lc = dir ? 35 - ci : ci - 4; return b * SEQ + lc * 64;
}

__device__ __forceinline__ void phase3(const Params& p, LAS unsigned char* lds) {
    const int tid = threadIdx.x, lane = tid & 63, wave = __builtin_amdgcn_readfirstlane(tid >> 6), fr = lane & 15, fq = lane >> 4;
    const int k = tid & 127, I = wave >> 1;
    const bf16* PA = (const bf16*)(p.ws + WS_PA);
    const float* lbv = (const float*)(p.ws + WS_LB);
    bf16* O = (bf16*)p.out;
    for (int it = blockIdx.x; it < 256; it += gridDim.x) {
        const int vh = it & 1, b = (it >> 1) & 7, hh = (it >> 4) & 3, dir = (it >> 6) & 1, br = it >> 7;
        const int qcol = (br ? 2048 : 0) + hh * 128;
        const int fcol = br ? 2560 + hh * 128 : 1024 + dir * 512 + hh * 128;
        const int vcol = (br ? 3072 : 512) + hh * 128 + vh * 64;
        const int lrcol = 3584 + dir * 16;
        for (int e = tid; e < 18432 / 16; e += NTHREADS) *(LAS u32x4*)(lds + SC_ST + e * 16) = (u32x4){0u, 0u, 0u, 0u};
        for (int e = tid; e < 10240 / 16; e += NTHREADS) *(LAS u32x4*)(lds + SC_P + e * 16) = (u32x4){0u, 0u, 0u, 0u};
        f32x4 S[4];
#pragma unroll
        for (int j = 0; j < 4; ++j) S[j] = (f32x4){0.f, 0.f, 0.f, 0.f};
        float lbk = 0.f, bgk = 0.f; float wg[16];
#pragma unroll
        for (int r = 0; r < 16; ++r) wg[r] = 0.f;
        if (br == 0) lbk = lbv[dir * 512 + hh * 128 + k];
        else { bgk = p.in[14][dir * 512 + hh * 128 + k];
#pragma unroll
            for (int r = 0; r < 16; ++r) wg[r] = p.in[13][(size_t)(dir * 16 + r) * 512 + hh * 128 + k]; }
        unsigned pqf[16]; u32x4 pv, plr = {0u, 0u, 0u, 0u};
#define SCAN_PREFETCH(ci_) do { const int base_ = scan_chunk_base((ci_), dir, b); \
            _Pragma("unroll") for (int j = 0; j < 16; ++j) { const int r_ = 16 * I + j; const bf16* pr_ = PA + (size_t)(base_ + (dir ? 63 - r_ : r_)) * NA; pqf[j] = (unsigned)pr_[qcol + k] | ((unsigned)pr_[fcol + k] << 16); } \
            { const int s_ = tid & 63; pv = *(const u32x4*)(PA + (size_t)(base_ + (dir ? 63 - s_ : s_)) * NA + vcol + (tid >> 6) * 8); } \
            if (br && tid < 128) { const int s_ = tid >> 1; plr = *(const u32x4*)(PA + (size_t)(base_ + (dir ? 63 - s_ : s_)) * NA + lrcol + 8 * (tid & 1)); } } while (0)
        SCAN_PREFETCH(0);
        __syncthreads();
#pragma unroll 1
        for (int ci = 0; ci < 36; ++ci) {
            int k_ = k, fr_ = fr, fq_ = fq; asm volatile("" : "+v"(k_), "+v"(fr_), "+v"(fq_));
            if (br && tid < 128) *(LAS u32x4*)(lds + SC_LR + tid * 16) = plr;
            __syncthreads();
            float cj[16], qv[16], kv[16];
            if (br == 0) {
#pragma unroll
                for (int j = 0; j < 16; ++j) {
                    const float fraw = bfhi(pqf[j]), qraw = bflo(pqf[j]);
                    const float f = lbk + (1.0f - lbk) * sigmoidf_(fraw);
                    cj[j] = __logf(f); kv[j] = 1.0f - f; qv[j] = qraw * sigmoidf_(qraw);
                }
            } else {
#pragma unroll
                for (int j = 0; j < 16; ++j) {
                    const LAS u32x4* lp = (const LAS u32x4*)(lds + SC_LR + (16 * I + j) * 32);
                    const u32x4 l0 = lp[0], l1 = lp[1];
                    float x = bgk;
                    x += bflo(l0.x) * wg[0] + bfhi(l0.x) * wg[1] + bflo(l0.y) * wg[2] + bfhi(l0.y) * wg[3];
                    x += bflo(l0.z) * wg[4] + bfhi(l0.z) * wg[5] + bflo(l0.w) * wg[6] + bfhi(l0.w) * wg[7];
                    x += bflo(l1.x) * wg[8] + bfhi(l1.x) * wg[9] + bflo(l1.y) * wg[10] + bfhi(l1.y) * wg[11];
                    x += bflo(l1.z) * wg[12] + bfhi(l1.z) * wg[13] + bflo(l1.w) * wg[14] + bfhi(l1.w) * wg[15];
                    const float ls = fminf(x, 0.f) - __logf(1.0f + __expf(-fabsf(x)));
                    cj[j] = ls * (1.0f / 16.0f); kv[j] = bfhi(pqf[j]); qv[j] = bflo(pqf[j]) * 0.08838834764831845f;
                }
            }
#pragma unroll
            for (int j = 1; j < 16; ++j) cj[j] += cj[j - 1];
            ((LAS float*)(lds + SC_TOT))[I * 128 + k_] = cj[15];
            {
                const int s_ = tid & 63, c8 = (tid >> 6) * 8;
                LAS bf16* vt = (LAS bf16*)(lds + SC_VT);
                const unsigned vw[4] = {pv.x, pv.y, pv.z, pv.w};
#pragma unroll
                for (int e = 0; e < 4; ++e) { vt[(c8 + 2 * e) * (RS64 / 2) + s_] = (bf16)(vw[e] & 0xffffu); vt[(c8 + 2 * e + 1) * (RS64 / 2) + s_] = (bf16)(vw[e] >> 16); }
            }
            __syncthreads();
            {
                const LAS float* tot = (const LAS float*)(lds + SC_TOT);
                const float t0 = tot[k_], t1 = tot[128 + k_], t2 = tot[256 + k_], t3 = tot[384 + k_];
                const float R1 = t0, R2 = t0 + t1, R3 = R2 + t2, R4 = R3 + t3;
                const float RI = I == 0 ? 0.f : (I == 1 ? R1 : (I == 2 ? R2 : R3));
                const float RN = I == 0 ? R1 : (I == 1 ? R2 : (I == 2 ? R3 : R4));
                const float eRI = __expf(RI);
                const float e1 = __expf(R1 - RN), e2 = __expf(R2 - RN), e3 = __expf(R3 - RN), e4 = __expf(R4 - RN);
                if (I == 3) ((LAS float*)(lds + SC_DEC))[k_] = __expf(R4);
                LAS bf16* qt = (LAS bf16*)(lds + SC_QT); LAS bf16* qh = (LAS bf16*)(lds + SC_QH); LAS bf16* kt = (LAS bf16*)(lds + SC_KT);
                unsigned khw[8];
#pragma unroll
                for (int j = 0; j < 16; ++j) {
                    const int r = 16 * I + j;
                    const float ec = __expf(cj[j]);
                    const float einv = __expf(fminf(-cj[j], 80.f));
                    const float g = __expf(cj[15] - cj[j]);
                    const float qtv = qv[j] * ec;
                    qt[r * (RS128 / 2) + k_] = (bf16)f2bf(qtv);
                    qh[r * (RS128 / 2) + k_] = (bf16)f2bf(qtv * eRI);
                    const float kg = kv[j] * g;
                    if (I == 0) { kt[(0 + r) * (RS128 / 2) + k_] = (bf16)f2bf(kv[j] * einv); kt[(16 + r) * (RS128 / 2) + k_] = (bf16)f2bf(kg); kt[(48 + r) * (RS128 / 2) + k_] = (bf16)f2bf(kg * e2); kt[(96 + r) * (RS128 / 2) + k_] = (bf16)f2bf(kg * e3); }
                    else if (I == 1) { kt[(16 + r) * (RS128 / 2) + k_] = (bf16)f2bf(kv[j] * einv); kt[(48 + r) * (RS128 / 2) + k_] = (bf16)f2bf(kg); kt[(96 + r) * (RS128 / 2) + k_] = (bf16)f2bf(kg * e3); }
                    else if (I == 2) { kt[(48 + r) * (RS128 / 2) + k_] = (bf16)f2bf(kv[j] * einv); kt[(96 + r) * (RS128 / 2) + k_] = (bf16)f2bf(kg); }
                    else { kt[(96 + r) * (RS128 / 2) + k_] = (bf16)f2bf(kv[j] * einv); }
                    const unsigned khv = f2bf(kg * e4);
                    if (j & 1) khw[j >> 1] |= khv << 16; else khw[j >> 1] = khv;
                }
                (void)e1;
                LAS u32x4* khp = (LAS u32x4*)(lds + SC_KH + k_ * RS64 + I * 32);
                khp[0] = (u32x4){khw[0], khw[1], khw[2], khw[3]}; khp[1] = (u32x4){khw[4], khw[5], khw[6], khw[7]};
            }
            if (ci + 1 < 36) SCAN_PREFETCH(ci + 1);
            __syncthreads();
            for (int ti = wave; ti < 10; ti += 8) {
                const int Ib = ti >= 6 ? 3 : (ti >= 3 ? 2 : (ti >= 1 ? 1 : 0)), Jb = ti - (Ib * (Ib + 1)) / 2, kbase = 8 * Ib * (Ib + 1);
                f32x4 acc = {0.f, 0.f, 0.f, 0.f};
#pragma unroll
                for (int ks = 0; ks < 4; ++ks) {
                    const bf16x8 a = *(const LAS bf16x8*)(lds + SC_QT + (16 * Ib + fr_) * RS128 + (32 * ks + 8 * fq_) * 2);
                    const bf16x8 bb = *(const LAS bf16x8*)(lds + SC_KT + (kbase + 16 * Jb + fr_) * RS128 + (32 * ks + 8 * fq_) * 2);
                    acc = __builtin_amdgcn_mfma_f32_16x16x32_bf16(a, bb, acc, 0, 0, 0);
                }
                LAS bf16* pp = (LAS bf16*)(lds + SC_P);
#pragma unroll
                for (int reg = 0; reg < 4; ++reg) {
                    const int t = 4 * fq_ + reg;
                    const float v = (Ib != Jb || fr_ <= t) ? acc[reg] : 0.f;
                    pp[(16 * Ib + t) * (RS64 / 2) + 16 * Jb + fr_] = (bf16)f2bf(v);
                }
            }
            const int I2 = wave >> 1, JcA = 2 * (wave & 1);
            f32x4 ao[2] = {{0.f, 0.f, 0.f, 0.f}, {0.f, 0.f, 0.f, 0.f}};
#pragma unroll
            for (int ks = 0; ks < 4; ++ks) {
                const bf16x8 a = *(const LAS bf16x8*)(lds + SC_QH + (16 * I2 + fr_) * RS128 + (32 * ks + 8 * fq_) * 2);
#pragma unroll
                for (int jj = 0; jj < 2; ++jj) {
                    const bf16x8 bb = *(const LAS bf16x8*)(lds + SC_ST + (16 * (JcA + jj) + fr_) * RS128 + (32 * ks + 8 * fq_) * 2);
                    ao[jj] = __builtin_amdgcn_mfma_f32_16x16x32_bf16(a, bb, ao[jj], 0, 0, 0);
                }
            }
            {
                const f32x4 dec = *(const LAS f32x4*)(lds + SC_DEC + (16 * wave + 4 * fq_) * 4);
#pragma unroll
                for (int jc = 0; jc < 4; ++jc) S[jc] = S[jc] * dec;
#pragma unroll
                for (int ks = 0; ks < 2; ++ks) {
                    const bf16x8 a = *(const LAS bf16x8*)(lds + SC_KH + (16 * wave + fr_) * RS64 + (32 * ks + 8 * fq_) * 2);
#pragma unroll
                    for (int jc = 0; jc < 4; ++jc) {
                        const bf16x8 bb = *(const LAS bf16x8*)(lds + SC_VT + (16 * jc + fr_) * RS64 + (32 * ks + 8 * fq_) * 2);
                        S[jc] = __builtin_amdgcn_mfma_f32_16x16x32_bf16(a, bb, S[jc], 0, 0, 0);
                    }
                }
            }
            __syncthreads();
            {
                const int nks = I2 < 2 ? 1 : 2;
                for (int ks = 0; ks < nks; ++ks) {
                    const bf16x8 a = *(const LAS bf16x8*)(lds + SC_P + (16 * I2 + fr_) * RS64 + (32 * ks + 8 * fq_) * 2);
#pragma unroll
                    for (int jj = 0; jj < 2; ++jj) {
                        const bf16x8 bb = *(const LAS bf16x8*)(lds + SC_VT + (16 * (JcA + jj) + fr_) * RS64 + (32 * ks + 8 * fq_) * 2);
                        ao[jj] = __builtin_amdgcn_mfma_f32_16x16x32_bf16(a, bb, ao[jj], 0, 0, 0);
                    }
                }
                if (ci >= 4) {
                    const int base = scan_chunk_base(ci, dir, b);
                    bf16* ob = O + (size_t)(br * 2 + dir) * MLAT * 512 + hh * 128 + vh * 64;
#pragma unroll
                    for (int reg = 0; reg < 4; ++reg) {
                        const int t = 16 * I2 + 4 * fq_ + reg; const size_t row = (size_t)(base + (dir ? 63 - t : t));
#pragma unroll
                        for (int jj = 0; jj < 2; ++jj) ob[row * 512 + 16 * (JcA + jj) + fr_] = (bf16)f2bf(ao[jj][reg]);
                    }
                }
#pragma unroll
                for (int jc = 0; jc < 4; ++jc) {
                    u32x2 w; w.x = pk2(S[jc][0], S[jc][1]); w.y = pk2(S[jc][2], S[jc][3]);
                    *(LAS u32x2*)(lds + SC_ST + (16 * jc + fr_) * RS128 + (16 * wave + 4 * fq_) * 2) = w;
                }
            }
            __syncthreads();
        }
#undef SCAN_PREFETCH
    }
}

__device__ __forceinline__ void phase5(const Params& p) {
    const int tid = threadIdx.x, lane = tid & 63, wave = tid >> 6;
    const int gw = blockIdx.x * NWAVES + wave, NGW = gridDim.x * NWAVES;
    const bf16* O = (const bf16*)p.out; const bf16* PB = (const bf16*)(p.ws + WS_PA); bf16* A12 = (bf16*)(p.ws + WS_A12);
    for (int m = gw; m < MLAT; m += NGW) {
#pragma unroll
        for (int hd = 0; hd < 8; ++hd) {
            const int br = hd >> 2, col = (hd & 3) * 128 + 2 * lane;
            const unsigned a = *(const unsigned*)(O + ((size_t)(br * 2 + 0) * MLAT + m) * 512 + col), bq = *(const unsigned*)(O + ((size_t)(br * 2 + 1) * MLAT + m) * 512 + col);
            const float o0 = bflo(a) + bflo(bq), o1 = bfhi(a) + bfhi(bq);
            const float rstd = 1.0f / sqrtf(wave_sum(o0 * o0 + o1 * o1) * (1.0f / 128.0f) + EPS);
            const unsigned g = *(const unsigned*)(PB + (size_t)m * NBB + br * 512 + col);
            const float* on = (br ? p.in[15] : p.in[12]) + 2 * lane;
            const float r0 = o0 * rstd * on[0] * siluf_(bflo(g)), r1 = o1 * rstd * on[1] * siluf_(bfhi(g));
            *(unsigned*)(A12 + (size_t)m * D + hd * 128 + 2 * lane) = pk2(r0, r1);
        }
    }
}

__device__ __forceinline__ void phase8(const Params& p) {
    const int tid = threadIdx.x, lane = tid & 63, wave = tid >> 6;
    const int gw = blockIdx.x * NWAVES + wave, NGW = gridDim.x * NWAVES;
    const float* x = p.in[0]; const float* post1 = p.in[7]; const float* pre2 = p.in[8];
    const float* modv = (const float*)(p.ws + WS_MODV); const bf16* y1 = (const bf16*)(p.ws + WS_Y1); bf16* h2 = (bf16*)(p.ws + WS_H1);
    for (int m = gw; m < MLAT; m += NGW) {
        const float* mv = modv + (size_t)(m / SEQ) * NMOD;
        f32x4 y[4], z[4]; float ss = 0.f;
#pragma unroll
        for (int j = 0; j < 4; ++j) {
            const u32x2 w = *(const u32x2*)(y1 + (size_t)m * D + 4 * lane + 256 * j);
            y[j] = (f32x4){bflo(w.x), bfhi(w.x), bflo(w.y), bfhi(w.y)};
            ss += (y[j][0] * y[j][0] + y[j][1] * y[j][1]) + (y[j][2] * y[j][2] + y[j][3] * y[j][3]);
        }
        const float rstd1 = 1.0f / sqrtf(wave_sum(ss) * (1.0f / D) + EPS);
        float s2 = 0.f;
#pragma unroll
        for (int j = 0; j < 4; ++j) {
            const int col = 4 * lane + 256 * j;
            const f32x4 xv = *(const f32x4*)(x + (size_t)m * D + col), w = *(const f32x4*)(post1 + col), g = *(const f32x4*)(mv + 2048 + col);
#pragma unroll
            for (int e = 0; e < 4; ++e) { z[j][e] = xv[e] + g[e] * (y[j][e] * rstd1 * w[e]); s2 += z[j][e] * z[j][e]; }
            *(f32x4*)(p.out + (size_t)m * D + col) = z[j];
        }
        const float rstdz = 1.0f / sqrtf(wave_sum(s2) * (1.0f / D) + EPS);
#pragma unroll
        for (int j = 0; j < 4; ++j) {
            const int col = 4 * lane + 256 * j;
            const f32x4 w = *(const f32x4*)(pre2 + col), sh = *(const f32x4*)(mv + 3072 + col), sc = *(const f32x4*)(mv + 4096 + col);
            f32x4 h;
#pragma unroll
            for (int e = 0; e < 4; ++e) h[e] = z[j][e] * rstdz * w[e] * (1.0f + sc[e]) + sh[e];
            u32x2 o; o.x = pk2(h[0], h[1]); o.y = pk2(h[2], h[3]);
            *(u32x2*)(h2 + (size_t)m * D + col) = o;
        }
    }
}

__device__ __forceinline__ void phase11(const Params& p) {
    const int tid = threadIdx.x, lane = tid & 63, wave = tid >> 6;
    const int gw = blockIdx.x * NWAVES + wave, NGW = gridDim.x * NWAVES;
    const float* post2 = p.in[9];
    const float* modv = (const float*)(p.ws + WS_MODV); const bf16* y2 = (const bf16*)(p.ws + WS_A12);
    for (int m = gw; m < MLAT; m += NGW) {
        const float* mv = modv + (size_t)(m / SEQ) * NMOD;
        f32x4 y[4]; float ss = 0.f;
#pragma unroll
        for (int j = 0; j < 4; ++j) {
            const u32x2 w = *(const u32x2*)(y2 + (size_t)m * D + 4 * lane + 256 * j);
            y[j] = (f32x4){bflo(w.x), bfhi(w.x), bflo(w.y), bfhi(w.y)};
            ss += (y[j][0] * y[j][0] + y[j][1] * y[j][1]) + (y[j][2] * y[j][2] + y[j][3] * y[j][3]);
        }
        const float rstd2 = 1.0f / sqrtf(wave_sum(ss) * (1.0f / D) + EPS);
#pragma unroll
        for (int j = 0; j < 4; ++j) {
            const int col = 4 * lane + 256 * j;
            const f32x4 w = *(const f32x4*)(post2 + col), g = *(const f32x4*)(mv + 5120 + col);
            f32x4 z = *(const f32x4*)(p.out + (size_t)m * D + col);
#pragma unroll
            for (int e = 0; e < 4; ++e) z[e] += g[e] * (y[j][e] * rstd2 * w[e]);
            *(f32x4*)(p.out + (size_t)m * D + col) = z;
        }
    }
}


#define GAS __attribute__((address_space(1)))
typedef GAS unsigned gu32;
#define RLX_AGENT __ATOMIC_RELAXED, __HIP_MEMORY_SCOPE_AGENT
#define XB_TMO      128
#define XB_XCNT(j)  (256  + 64 * (j))
#define XB_XSUB(j)  (1280 + 64 * (j))
#define XB_XGEN(j)  (2304 + 64 * (j))
#define XB_TOP      3328
#define XB_TOPGEN   3392
#define XCD_BAR_WORDS 3456
#define XB_SPIN_CAP (1u << 18)

__device__ __forceinline__ unsigned xb_ld(unsigned* p)              { return __hip_atomic_load(p, __ATOMIC_RELAXED, __HIP_MEMORY_SCOPE_AGENT); }
__device__ __forceinline__ unsigned xb_add(unsigned* p, unsigned v) { return __hip_atomic_fetch_add(p, v, __ATOMIC_RELAXED, __HIP_MEMORY_SCOPE_AGENT); }
__device__ __forceinline__ unsigned xb_xcc_id() { return (unsigned)__builtin_amdgcn_s_getreg((3 << 11) | 20) & 0xFu; }
#define XB_SPIN(cond, bar) do { unsigned _sp = 0; while (cond) { __builtin_amdgcn_s_sleep(1); \
    if ((++_sp & 255u) == 0u) { if (xb_ld(&(bar)[XB_TMO])) break; if (_sp > XB_SPIN_CAP) { atomicAdd(&(bar)[XB_TMO], 1u); break; } } } } while (0)

struct XcdBarrier {
    unsigned* bar; unsigned x;
    volatile LAS unsigned* st;
};

__device__ __forceinline__ XcdBarrier xcd_barrier_post(unsigned* bar, volatile LAS unsigned* st) {
    XcdBarrier b; b.bar = bar; b.x = xb_xcc_id(); b.st = st;
    if (threadIdx.x == 0) (void)xb_add(&bar[XB_XCNT(b.x)], 1u);
    return b;
}
__device__ __forceinline__ void xcd_barrier_complete(unsigned* bar, unsigned x, unsigned& nloc, unsigned& nx) {
    const unsigned G = gridDim.x * gridDim.y * gridDim.z;
    unsigned sum, cnt, mine, sp = 0u;
    for (;;) {
        sum = 0u; cnt = 0u; mine = 0u;
#pragma unroll
        for (unsigned j = 0; j < 16; ++j) { const unsigned c = xb_ld(&bar[XB_XCNT(j)]); sum += c; cnt += (c > 0u) ? 1u : 0u; mine = (j == x) ? c : mine; }
        if (sum == G) break;
        __builtin_amdgcn_s_sleep(1);
        if ((++sp & 255u) == 0u) { if (xb_ld(&bar[XB_TMO])) break; if (sp > XB_SPIN_CAP) { atomicAdd(&bar[XB_TMO], 1u); break; } }
    }
    nloc = mine > 0u ? mine : 1u; nx = cnt > 0u ? cnt : 1u;
}

__device__ __forceinline__ void xcd_barrier(const XcdBarrier& b) {
    asm volatile("s_waitcnt vmcnt(0)" ::: "memory");
    __syncthreads();
    if (threadIdx.x == 0) {
        unsigned* bar = b.bar;
        __builtin_amdgcn_s_waitcnt(0);
        unsigned nloc = b.st[0], nx = b.st[1];
        if (nloc == 0u) { xcd_barrier_complete(bar, b.x, nloc, nx); b.st[0] = nloc; b.st[1] = nx; }
        const unsigned old = xb_add(&bar[XB_XSUB(b.x)], 1u);
        const unsigned gen = old / nloc;
        if (old + 1u == (gen + 1u) * nloc) {
            __builtin_amdgcn_fence(__ATOMIC_RELEASE, "agent");
            asm volatile("s_waitcnt vmcnt(0)" ::: "memory");
            const unsigned og = xb_add(&bar[XB_TOP], 1u);
            const unsigned tg = og / nx;
            if (og + 1u == (tg + 1u) * nx) xb_add(&bar[XB_TOPGEN], 1u);
            else XB_SPIN(xb_ld(&bar[XB_TOPGEN]) == tg, bar);
            __builtin_amdgcn_fence(__ATOMIC_ACQUIRE, "agent");
            xb_add(&bar[XB_XGEN(b.x)], 1u);
            asm volatile("s_waitcnt vmcnt(0)" ::: "memory");
        } else {
            XB_SPIN(xb_ld(&bar[XB_XGEN(b.x)]) == gen, bar);
            __builtin_amdgcn_fence(__ATOMIC_ACQUIRE, "agent");
            asm volatile("s_waitcnt vmcnt(0)" ::: "memory");
        }
    }
    __syncthreads();
}

__global__ void __launch_bounds__(NTHREADS, 2) fwd_kernel(Params p) {
    extern __shared__ __attribute__((aligned(16))) unsigned char lds_raw[];
    LAS unsigned char* lds = (LAS unsigned char*)lds_raw;
    for (int u = threadIdx.x; u < (LDS_BYTES - LDSCTL_OFF) / 4; u += NTHREADS) ((LAS unsigned*)(lds + LDSCTL_OFF))[u] = 0u;
    __syncthreads();
    const XcdBarrier bar = xcd_barrier_post((unsigned*)(p.ws + WS_CTL), (volatile LAS unsigned*)(lds + LDSCTL_OFF) + 8);
    unsigned char* ws = p.ws;
    const int lo = p.ph_lo, hi = p.ph_hi;
#ifndef PHASE_MASK
#define PHASE_MASK 0xFFF
#endif
#define IN(k) ((((PHASE_MASK) >> (k)) & 1) && lo <= (k) && (k) < hi)
#define SYNC(k) do { if (IN(k) && IN((k) + 1)) xcd_barrier(bar); } while (0)
    if (IN(0)) phase0(p, lds);
    SYNC(0);
    if (IN(1)) phase1(p);
    SYNC(1);
    if (IN(2)) { pg8::Gemm g{(const bf16*)(ws + WS_H1), (const bf16*)(ws + WS_WA), MALL, NA, D, D}; pg8::StaticOrder S; S.init(MALL, NA, (int)gridDim.x, (int)blockIdx.x);
        pg8::EpiStoreBf16 e{(bf16*)(ws + WS_PA), NA}; pg8::gemm_phase<pg8::EpiStoreBf16, pg8::StaticOrder, true, true>(lds, g, S, e); }
    SYNC(2);
    if (IN(3)) phase3(p, lds);
    SYNC(3);
    if (IN(4)) { pg8::Gemm g{(const bf16*)(ws + WS_H1), (const bf16*)(ws + WS_WB), MLAT, NBB, D, D}; pg8::StaticOrder S; S.init(MLAT, NBB, (int)gridDim.x, (int)blockIdx.x);
        pg8::EpiStoreBf16 e{(bf16*)(ws + WS_PA), NBB}; pg8::gemm_phase<pg8::EpiStoreBf16, pg8::StaticOrder, true, true>(lds, g, S, e); }
    SYNC(4);
    if (IN(5)) phase5(p);
    SYNC(5);
    if (IN(6)) {
        pg8::StaticOrder S; S.init(MLAT, D, (int)gridDim.x, (int)blockIdx.x);
        { pg8::Gemm g{(const bf16*)(ws + WS_A12), (const bf16*)(ws + WS_WBRH), MLAT, D, 512, D};
          pg8::EpiBranch<0> e{(bf16*)(ws + WS_H1), D, (const bf16*)(ws + WS_PA), NBB, 1024}; pg8::gemm_phase<pg8::EpiBranch<0>, pg8::StaticOrder, true, true>(lds, g, S, e); }
        { pg8::Gemm g{(const bf16*)(ws + WS_A12) + 512, (const bf16*)(ws + WS_WBRG), MLAT, D, 512, D};
          pg8::EpiBranch<1> e{(bf16*)(ws + WS_H1), D, (const bf16*)(ws + WS_PA), NBB, 2048}; pg8::gemm_phase<pg8::EpiBranch<1>, pg8::StaticOrder, true, true>(lds, g, S, e); }
    }
    SYNC(6);
    if (IN(7)) { pg8::Gemm g{(const bf16*)(ws + WS_H1), (const bf16*)(ws + WS_WOUT), MLAT, D, D, D}; pg8::StaticOrder S; S.init(MLAT, D, (int)gridDim.x, (int)blockIdx.x);
        pg8::EpiStoreBf16 e{(bf16*)(ws + WS_Y1), D}; pg8::gemm_phase<pg8::EpiStoreBf16, pg8::StaticOrder, true, true>(lds, g, S, e); }
    SYNC(7);
    if (IN(8)) phase8(p);
    SYNC(8);
    if (IN(9)) { pg8::Gemm g{(const bf16*)(ws + WS_H1), (const bf16*)(ws + WS_WGU), MLAT, NGU, D, D}; pg8::StaticOrder S; S.init(MLAT, NGU, (int)gridDim.x, (int)blockIdx.x);
        pg8::EpiSwiGLU e{(bf16*)(ws + WS_PA), DFF}; pg8::gemm_phase<pg8::EpiSwiGLU, pg8::StaticOrder, true, true>(lds, g, S, e); }
    SYNC(9);
    if (IN(10)) { pg8::Gemm g{(const bf16*)(ws + WS_PA), (const bf16*)(ws + WS_WD), MLAT, D, DFF, DFF}; pg8::StaticOrder S; S.init(MLAT, D, (int)gridDim.x, (int)blockIdx.x);
        pg8::EpiStoreBf16 e{(bf16*)(ws + WS_A12), D}; pg8::gemm_phase<pg8::EpiStoreBf16, pg8::StaticOrder, true, true>(lds, g, S, e); }
    SYNC(10);
    if (IN(11)) phase11(p);
#undef IN
#undef SYNC
}

extern "C" void kernel_launch(void* const* d_in, const int* in_sizes, int n_in, void* d_out, int out_size, void* d_ws, size_t ws_size, hipStream_t stream) {
    static int grid = 0;
    if (grid == 0) {
        if (n_in != 22 || out_size != MLAT * D || ws_size < WS_END) { fprintf(stderr, "kernel_launch: unexpected shapes (n_in %d out %d ws %zu)\n", n_in, out_size, ws_size); grid = -1; return; }
        int dev = 0, cus = 0, per_cu = 0;
        hipGetDevice(&dev);
        hipDeviceGetAttribute(&cus, hipDeviceAttributeMultiprocessorCount, dev);
        hipFuncSetAttribute((const void*)fwd_kernel, hipFuncAttributeMaxDynamicSharedMemorySize, LDS_BYTES);
        hipOccupancyMaxActiveBlocksPerMultiprocessor(&per_cu, (const void*)fwd_kernel, NTHREADS, LDS_BYTES);
        if (per_cu < 1) { fprintf(stderr, "kernel_launch: occupancy query says %d blocks/CU\n", per_cu); per_cu = 1; }
        grid = cus * 1;
        (void)hipGetLastError();
    }
    if (grid < 0) return;
    Params p{};
    for (int i = 0; i < 22; ++i) p.in[i] = (const float*)d_in[i];
    p.out = (float*)d_out; p.ws = (unsigned char*)d_ws; p.ph_lo = 0; p.ph_hi = 12;
    if (hipMemsetAsync((char*)d_ws + WS_CTL, 0, CTL_ZERO_BYTES, stream) != hipSuccess) { fprintf(stderr, "kernel_launch: memset of the control words failed\n"); return; }
    hipLaunchKernelGGL(fwd_kernel, dim3(grid), dim3(NTHREADS), LDS_BYTES, stream, p);
    const hipError_t le = hipPeekAtLastError();
    if (le != hipSuccess) fprintf(stderr, "kernel_launch: launch failed: %s (grid %d)\n", hipGetErrorName(le), grid);
}
```

```cpp
#include <hip/hip_runtime.h>
#include <cstdio>
#include <cstdint>

typedef unsigned short bf16;
typedef short bf16x8 __attribute__((ext_vector_type(8)));
typedef float f32x4 __attribute__((ext_vector_type(4)));
typedef unsigned u32x4 __attribute__((ext_vector_type(4)));
typedef unsigned u32x2 __attribute__((ext_vector_type(2)));
#define LAS __attribute__((address_space(3)))

constexpr int NB = 8, SEQ = 2048, CTXL = 256, D = 1024, DFF = 2816;
constexpr int MLAT = NB * SEQ, MCTX = NB * CTXL, MALL = MLAT + MCTX;
constexpr int INW = 6688, NMOD = 6144;
constexpr int NA = 3840;
constexpr int NBB = 3072;
constexpr int NGU = 2 * DFF;
constexpr float EPS = 1e-6f;
constexpr int NWAVES = 8, NTHREADS = 512;
constexpr int LDS_BYTES = 147456;
constexpr int LDSCTL_OFF = 147200;

constexpr size_t MiB = 1u << 20;
constexpr size_t WS_CTL = 0, CTL_ZERO_BYTES = 65536;
constexpr size_t WS_MODV = 1 * MiB;
constexpr size_t WS_LB = WS_MODV + 512 * 1024;
constexpr size_t WS_WA = 2 * MiB;
constexpr size_t WS_WB = 10 * MiB;
constexpr size_t WS_WBRH = 16 * MiB;
constexpr size_t WS_WBRG = 17 * MiB;
constexpr size_t WS_WOUT = 18 * MiB;
constexpr size_t WS_WGU = 20 * MiB;
constexpr size_t WS_WD = 31 * MiB;
constexpr size_t WS_H1 = 37 * MiB;
constexpr size_t WS_PA = 73 * MiB;
constexpr size_t WS_A12 = 169 * MiB;
constexpr size_t WS_Y1 = 201 * MiB;
constexpr size_t WS_END = 233 * MiB;

struct Params {
    const float* in[22];
    float* out;
    unsigned char* ws;
    int ph_lo, ph_hi;
};

__device__ __forceinline__ unsigned f2bf(float f) { unsigned u = __builtin_bit_cast(unsigned, f); return (u + 0x7fffu + ((u >> 16) & 1u)) >> 16; }
__device__ __forceinline__ unsigned pk2(float lo, float hi) { return f2bf(lo) | (f2bf(hi) << 16); }
__device__ __forceinline__ float bf2f(unsigned b) { return __builtin_bit_cast(float, b << 16); }
__device__ __forceinline__ float bflo(unsigned w) { return __builtin_bit_cast(float, w << 16); }
__device__ __forceinline__ float bfhi(unsigned w) { return __builtin_bit_cast(float, w & 0xffff0000u); }
__device__ __forceinline__ float sigmoidf_(float x) { return 1.0f / (1.0f + __expf(-x)); }
__device__ __forceinline__ float siluf_(float x) { return x / (1.0f + __expf(-x)); }
__device__ __forceinline__ float wave_sum(float v) {
#pragma unroll
    for (int o = 1; o < 64; o <<= 1) v += __shfl_xor(v, o);
    return v;
}

__device__ __forceinline__ void transpose_item(const float* W, int ldw, int c0, int ncols, int Kdst, bf16* WT, int row0, int mode, LAS float* scr, int item, int lane) {
    const int nblk = ncols / 32, kb = item / nblk, nb = item % nblk, k0 = 64 * kb, n0 = 32 * nb;
#pragma unroll 8
    for (int i = 0; i < 32; ++i) { const int kk = 2 * i + (lane >> 5); scr[kk * 33 + (lane & 31)] = W[(size_t)(k0 + kk) * ldw + c0 + n0 + (lane & 31)]; }
    asm volatile("s_waitcnt lgkmcnt(0)" ::: "memory");
    const int c = lane & 7;
#pragma unroll
    for (int j = 0; j < 4; ++j) {
        const int n = (lane >> 3) + 8 * j; const LAS float* s = scr + (8 * c) * 33 + n;
        u32x4 o; o.x = pk2(s[0 * 33], s[1 * 33]); o.y = pk2(s[2 * 33], s[3 * 33]); o.z = pk2(s[4 * 33], s[5 * 33]); o.w = pk2(s[6 * 33], s[7 * 33]);
        const int nn = n0 + n;
        const int drow = mode == 0 ? row0 + nn : (2 * (nn & ~15) + (nn & 15) + (mode == 2 ? 16 : 0));
        *(u32x4*)(WT + (size_t)drow * Kdst + k0 + 8 * c) = o;
    }
    asm volatile("s_waitcnt lgkmcnt(0)" ::: "memory");
}

__device__ __forceinline__ void phase0(const Params& p, LAS unsigned char* lds) {
    const int tid = threadIdx.x, lane = tid & 63, wave = tid >> 6;
    unsigned char* ws = p.ws;
    {
        LAS float* sil = (LAS float*)lds;
        LAS float* red = (LAS float*)(lds + 49152);
        const float* cv = p.in[1]; const float* cc = p.in[3]; const float* wm = p.in[4]; const float* bm = p.in[5];
        float* modv = (float*)(ws + WS_MODV);
        for (int it = blockIdx.x; it < NMOD / 64; it += gridDim.x) {
            __syncthreads();
            for (int e = tid; e < 9 * 1024; e += NTHREADS) { const int r = e >> 10, k = e & 1023; const float v = r < 8 ? cv[r * 1024 + k] : cc[k]; sil[k * 12 + r] = siluf_(v); }
            __syncthreads();
            const int j = it * 64 + lane;
            float acc[9];
#pragma unroll
            for (int r = 0; r < 9; ++r) acc[r] = 0.f;
            const int kbeg = wave * 128;
#pragma unroll 4
            for (int k = kbeg; k < kbeg + 128; ++k) {
                const float w = wm[(size_t)k * NMOD + j];
                const f32x4 s0 = *(const LAS f32x4*)(sil + k * 12), s1 = *(const LAS f32x4*)(sil + k * 12 + 4); const float s8 = sil[k * 12 + 8];
                acc[0] += s0[0] * w; acc[1] += s0[1] * w; acc[2] += s0[2] * w; acc[3] += s0[3] * w;
                acc[4] += s1[0] * w; acc[5] += s1[1] * w; acc[6] += s1[2] * w; acc[7] += s1[3] * w; acc[8] += s8 * w;
            }
#pragma unroll
            for (int r = 0; r < 9; ++r) red[(wave * 9 + r) * 64 + lane] = acc[r];
            __syncthreads();
            for (int e = tid; e < 9 * 64; e += NTHREADS) {
                const int r = e >> 6, l = e & 63; float s = 0.f;
#pragma unroll
                for (int w2 = 0; w2 < 8; ++w2) s += red[(w2 * 9 + r) * 64 + l];
                modv[(size_t)r * NMOD + it * 64 + l] = s + bm[it * 64 + l];
            }
        }
        __syncthreads();
    }
    {
        const int gt = blockIdx.x * NTHREADS + tid, GT = gridDim.x * NTHREADS;
        const float* hl = p.in[11]; float* lb = (float*)(ws + WS_LB);
        for (int e = gt; e < 1024; e += GT) lb[e] = sigmoidf_(hl[e] - hl[1024 + e]);
        u32x4* padp = (u32x4*)(ws + WS_WA + (size_t)3616 * 1024 * 2); const u32x4 z = {0u, 0u, 0u, 0u};
        for (int e = gt; e < 224 * 1024 * 2 / 16; e += GT) padp[e] = z;
    }
    {
        LAS float* scr = (LAS float*)(lds + wave * 8448);
        const int gw = blockIdx.x * NWAVES + wave, NGW = gridDim.x * NWAVES;
        const float* w_in = p.in[10];
        bf16* WA = (bf16*)(ws + WS_WA); bf16* WB = (bf16*)(ws + WS_WB);
        constexpr int I1 = 16 * 64, I2 = 16 * 48, I3 = 16 * 1, I4 = 16 * 16, I5 = 16 * 16, I6 = 16 * 64, I7 = 8 * 32, I8 = 8 * 32, I9 = 16 * 32, I10 = 16 * 88, I11 = 16 * 88, I12 = 44 * 32;
        constexpr int NIT = I1 + I2 + I3 + I4 + I5 + I6 + I7 + I8 + I9 + I10 + I11 + I12;
        for (int it = gw; it < NIT; it += NGW) {
            int r = it;
            if (r < I1) { transpose_item(w_in, INW, 0, 2048, 1024, WA, 0, 0, scr, r, lane); continue; } r -= I1;
            if (r < I2) { transpose_item(w_in, INW, 2560, 1536, 1024, WA, 2048, 0, scr, r, lane); continue; } r -= I2;
            if (r < I3) { transpose_item(w_in, INW, 4608, 32, 1024, WA, 3584, 0, scr, r, lane); continue; } r -= I3;
            if (r < I4) { transpose_item(w_in, INW, 2048, 512, 1024, WB, 0, 0, scr, r, lane); continue; } r -= I4;
            if (r < I5) { transpose_item(w_in, INW, 4096, 512, 1024, WB, 512, 0, scr, r, lane); continue; } r -= I5;
            if (r < I6) { transpose_item(w_in, INW, 4640, 2048, 1024, WB, 1024, 0, scr, r, lane); continue; } r -= I6;
            if (r < I7) { transpose_item(p.in[16], 1024, 0, 1024, 512, (bf16*)(ws + WS_WBRH), 0, 0, scr, r, lane); continue; } r -= I7;
            if (r < I8) { transpose_item(p.in[17], 1024, 0, 1024, 512, (bf16*)(ws + WS_WBRG), 0, 0, scr, r, lane); continue; } r -= I8;
            if (r < I9) { transpose_item(p.in[18], 1024, 0, 1024, 1024, (bf16*)(ws + WS_WOUT), 0, 0, scr, r, lane); continue; } r -= I9;
            if (r < I10) { transpose_item(p.in[19], DFF, 0, DFF, 1024, (bf16*)(ws + WS_WGU), 0, 1, scr, r, lane); continue; } r -= I10;
            if (r < I11) { transpose_item(p.in[20], DFF, 0, DFF, 1024, (bf16*)(ws + WS_WGU), 0, 2, scr, r, lane); continue; } r -= I11;
            transpose_item(p.in[21], 1024, 0, 1024, DFF, (bf16*)(ws + WS_WD), 0, 0, scr, r, lane);
        }
    }
}

__device__ __forceinline__ void phase1(const Params& p) {
    const int tid = threadIdx.x, lane = tid & 63, wave = tid >> 6;
    const int gw = blockIdx.x * NWAVES + wave, NGW = gridDim.x * NWAVES;
    const float* x = p.in[0]; const float* ctx = p.in[2]; const float* pre1 = p.in[6];
    const float* modv = (const float*)(p.ws + WS_MODV); bf16* h1 = (bf16*)(p.ws + WS_H1);
    for (int m = gw; m < MALL; m += NGW) {
        const float* src = m < MLAT ? x + (size_t)m * D : ctx + (size_t)(m - MLAT) * D;
        const float* mv = modv + (size_t)(m < MLAT ? m / SEQ : 8) * NMOD;
        f32x4 v[4]; float ss = 0.f;
#pragma unroll
        for (int j = 0; j < 4; ++j) { v[j] = ((const f32x4*)src)[lane + 64 * j]; ss += (v[j][0] * v[j][0] + v[j][1] * v[j][1]) + (v[j][2] * v[j][2] + v[j][3] * v[j][3]); }
        const float rstd = 1.0f / sqrtf(wave_sum(ss) * (1.0f / D) + EPS);
#pragma unroll
        for (int j = 0; j < 4; ++j) {
            const int col = 4 * lane + 256 * j;
            const f32x4 w = *(const f32x4*)(pre1 + col), sh = *(const f32x4*)(mv + col), sc = *(const f32x4*)(mv + 1024 + col);
            f32x4 h;
#pragma unroll
            for (int e = 0; e < 4; ++e) h[e] = v[j][e] * rstd * w[e] * (1.0f + sc[e]) + sh[e];
            u32x2 o; o.x = pk2(h[0], h[1]); o.y = pk2(h[2], h[3]);
            *(u32x2*)(h1 + (size_t)m * D + col) = o;
        }
    }
}

namespace pg8 {
#define PG8_LAS __attribute__((address_space(3)))
typedef unsigned short bf16_t;
typedef short bf16x8 __attribute__((ext_vector_type(8)));
typedef float f32x4 __attribute__((ext_vector_type(4)));
typedef unsigned u32x4 __attribute__((ext_vector_type(4)));
constexpr int BM = 256, BK = 64, HALF = 128, HTB = HALF * BK * 2  , STAGE_BYTES = 8 * HTB, NXCD = 8, WGM = 8;

__host__ __device__ __forceinline__ int lds_byte(int r, int c) { const int st = (r >> 4) * 2 + (c >> 5), rr = r & 15, cc = c & 31, ob = rr * 64 + cc * 2; return st * 1024 + (ob ^ (((ob >> 9) & 1) << 5)); }
__host__ __device__ __forceinline__ void stage_rc(int b, int& R, int& C) { const int st = b / 1024, sb = b % 1024, swz = sb ^ (((sb >> 9) & 1) << 5); R = (st >> 1) * 16 + swz / 64; C = (st & 1) * 32 + (swz % 64) / 2; }
__host__ __device__ __forceinline__ int perm32(int rho) { const int n = rho >> 4, i = rho & 15; return 8 * (i >> 2) + 4 * n + (i & 3); }

struct Unit { int pm, pn; };
struct Gemm { const bf16_t* A; const bf16_t* Bt; int M, N, K, lda; };

struct StaticOrder {
    int nM, nN, nwg, G, c;
    __host__ __device__ void init(int M, int N, int G_, int c_) { nM = M / BM; nN = N / BM; nwg = nM * nN; G = G_; c = c_; }
    __host__ __device__ bool next(int i, Unit& u) const {
        const long L = (long)i * G + c; if (L >= nwg) return false;
        int wgid = (int)L; { const int q = nwg / NXCD, r = nwg % NXCD, xcd = wgid % NXCD, off = wgid / NXCD; wgid = (xcd < r ? xcd * (q + 1) : r * (q + 1) + (xcd - r) * q) + off; }
        const int nig = WGM * nN, gid = wgid / nig, fm = gid * WGM, gsz = (nM - fm) < WGM ? (nM - fm) : WGM;
        u.pm = fm + ((wgid % nig) % gsz); u.pn = (wgid % nig) / gsz; return true;
    }
    __device__ __forceinline__ void a_ready(const Unit&) const {}
    __device__ __forceinline__ void done(const Unit&) const {}
};

__device__ __forceinline__ unsigned cvt_pk_bf16(float lo, float hi) { unsigned r; asm volatile("v_cvt_pk_bf16_f32 %0, %1, %2" : "=v"(r) : "v"(lo), "v"(hi)); return r; }
__device__ __forceinline__ float sigm(float x) { return __builtin_amdgcn_rcpf(1.0f + __expf(-x)); }
__device__ __forceinline__ float lo16(unsigned w) { return __builtin_bit_cast(float, w << 16); }
__device__ __forceinline__ float hi16(unsigned w) { return __builtin_bit_cast(float, w & 0xffff0000u); }

struct EpiStoreBf16 {
    static constexpr bool PERM = true, AFTER_DRAIN = false;
    bf16_t* O; int ldc;
    __device__ __forceinline__ void operator()(const f32x4 (&acc)[2][2][4][2], const Unit& u, int wr, int wc, int fr, int fq) const {
        const int row0 = u.pm * BM + wr * 64 + fr, col0 = u.pn * BM + wc * 32 + 8 * fq;
#pragma unroll
        for (int ai = 0; ai < 2; ++ai)
#pragma unroll
            for (int m = 0; m < 4; ++m) { bf16_t* rowp = O + (size_t)(row0 + ai * HALF + m * 16) * ldc + col0;
#pragma unroll
                for (int bj = 0; bj < 2; ++bj) { const f32x4 v0 = acc[ai][bj][m][0], v1 = acc[ai][bj][m][1];
                    u32x4 w; w.x = cvt_pk_bf16(v0[0], v0[1]); w.y = cvt_pk_bf16(v0[2], v0[3]); w.z = cvt_pk_bf16(v1[0], v1[1]); w.w = cvt_pk_bf16(v1[2], v1[3]);
                    *(u32x4*)(rowp + bj * HALF) = w; } }
    }
};
struct EpiProjA {
    static constexpr bool PERM = true, AFTER_DRAIN = false;
    bf16_t* O; int ldc; const float* lb;
    __device__ __forceinline__ void operator()(const f32x4 (&acc)[2][2][4][2], const Unit& u, int wr, int wc, int fr, int fq) const {
        const int row0 = u.pm * BM + wr * 64 + fr, col0 = u.pn * BM + wc * 32 + 8 * fq;
        const int mode = (u.pn < 2) ? 1 : ((u.pn >= 4 && u.pn < 8) ? 2 : ((u.pn == 8 || u.pn == 9) ? 3 : 0));
        f32x4 lbv[2][2];
#pragma unroll
        for (int bj = 0; bj < 2; ++bj)
#pragma unroll
            for (int n = 0; n < 2; ++n) lbv[bj][n] = mode == 2 ? *(const f32x4*)(lb + (col0 - 1024) + bj * HALF + 4 * n) : (f32x4){0.f, 0.f, 0.f, 0.f};
#pragma unroll
        for (int ai = 0; ai < 2; ++ai)
#pragma unroll
            for (int m = 0; m < 4; ++m) { bf16_t* rowp = O + (size_t)(row0 + ai * HALF + m * 16) * ldc + col0;
#pragma unroll
                for (int bj = 0; bj < 2; ++bj) { f32x4 v0 = acc[ai][bj][m][0], v1 = acc[ai][bj][m][1];
                    if (mode == 1) {
#pragma unroll
                        for (int e = 0; e < 4; ++e) { v0[e] = v0[e] * sigm(v0[e]); v1[e] = v1[e] * sigm(v1[e]); }
                    } else if (mode == 2) {
#pragma unroll
                        for (int e = 0; e < 4; ++e) { v0[e] = lbv[bj][0][e] + (1.0f - lbv[bj][0][e]) * sigm(v0[e]); v1[e] = lbv[bj][1][e] + (1.0f - lbv[bj][1][e]) * sigm(v1[e]); }
                    } else if (mode == 3) { v0 = v0 * 0.08838834764831845f; v1 = v1 * 0.08838834764831845f; }
                    u32x4 w; w.x = cvt_pk_bf16(v0[0], v0[1]); w.y = cvt_pk_bf16(v0[2], v0[3]); w.z = cvt_pk_bf16(v1[0], v1[1]); w.w = cvt_pk_bf16(v1[2], v1[3]);
                    *(u32x4*)(rowp + bj * HALF) = w; } }
    }
};
template <int SECOND> struct EpiBranch {
    static constexpr bool PERM = true, AFTER_DRAIN = false;
    bf16_t* T; int ldt; const bf16_t* G; int ldg; int gcol0;
    __device__ __forceinline__ void operator()(const f32x4 (&acc)[2][2][4][2], const Unit& u, int wr, int wc, int fr, int fq) const {
        const int row0 = u.pm * BM + wr * 64 + fr, col0 = u.pn * BM + wc * 32 + 8 * fq;
#pragma unroll
        for (int ai = 0; ai < 2; ++ai)
#pragma unroll
            for (int m = 0; m < 4; ++m) { const size_t row = (size_t)(row0 + ai * HALF + m * 16);
#pragma unroll
                for (int bj = 0; bj < 2; ++bj) { const f32x4 v0 = acc[ai][bj][m][0], v1 = acc[ai][bj][m][1];
                    const u32x4 g = *(const u32x4*)(G + row * ldg + gcol0 + col0 + bj * HALF);
                    float r[8] = {sigm(lo16(g.x)) * v0[0], sigm(hi16(g.x)) * v0[1], sigm(lo16(g.y)) * v0[2], sigm(hi16(g.y)) * v0[3],
                                  sigm(lo16(g.z)) * v1[0], sigm(hi16(g.z)) * v1[1], sigm(lo16(g.w)) * v1[2], sigm(hi16(g.w)) * v1[3]};
                    bf16_t* tp = T + row * ldt + col0 + bj * HALF;
                    if (SECOND) { const u32x4 t = *(const u32x4*)tp;
                        r[0] += lo16(t.x); r[1] += hi16(t.x); r[2] += lo16(t.y); r[3] += hi16(t.y); r[4] += lo16(t.z); r[5] += hi16(t.z); r[6] += lo16(t.w); r[7] += hi16(t.w); }
                    u32x4 w; w.x = cvt_pk_bf16(r[0], r[1]); w.y = cvt_pk_bf16(r[2], r[3]); w.z = cvt_pk_bf16(r[4], r[5]); w.w = cvt_pk_bf16(r[6], r[7]);
                    *(u32x4*)tp = w; } }
    }
};
struct EpiSwiGLU {
    static constexpr bool PERM = false, AFTER_DRAIN = false;
    bf16_t* ACT; int ldc;
    __device__ __forceinline__ void operator()(const f32x4 (&acc)[2][2][4][2], const Unit& u, int wr, int wc, int fr, int fq) const {
        const int row0 = u.pm * BM + wr * 64 + fr, ch0 = u.pn * HALF + wc * 16 + 4 * fq;
#pragma unroll
        for (int ai = 0; ai < 2; ++ai)
#pragma unroll
            for (int m = 0; m < 4; ++m) { bf16_t* rowp = ACT + (size_t)(row0 + ai * HALF + m * 16) * ldc + ch0;
#pragma unroll
                for (int bj = 0; bj < 2; ++bj) { const f32x4 g = acc[ai][bj][m][0], up = acc[ai][bj][m][1];
                    float r[4];
#pragma unroll
                    for (int e = 0; e < 4; ++e) r[e] = g[e] * sigm(g[e]) * up[e];
                    u32x2 w; w.x = cvt_pk_bf16(r[0], r[1]); w.y = cvt_pk_bf16(r[2], r[3]);
                    *(u32x2*)(rowp + bj * 64) = w; } }
    }
};

template <class Epi, class Sched, bool ALIGN_EPI = false, bool SP2 = false>
__device__ __forceinline__ void gemm_phase(PG8_LAS unsigned char* lds, const Gemm g, const Sched& S, const Epi& E) {
    const int tid = threadIdx.x, wid = __builtin_amdgcn_readfirstlane(tid >> 6), lane = tid & 63, wr = wid >> 2, wc = wid & 3, fr = lane & 15, fq = lane >> 4;
    const int K = g.K, nt = K / BK;
    unsigned voffA[2], voffB[2];
#pragma unroll
    for (int i = 0; i < 2; ++i) { int R, C; stage_rc(tid * 16 + i * 8192, R, C); const int Rb = Epi::PERM ? ((R & ~31) + perm32(R & 31)) : R;
        voffA[i] = (unsigned)(R * g.lda + C) * 2u; voffB[i] = (unsigned)(Rb * K + C) * 2u; }
    const size_t kstep = (size_t)(BK * 2);
    const size_t hstepA = (size_t)HALF * g.lda * 2, hstepB = (size_t)HALF * K * 2;
    const size_t tstepA = 2 * hstepA, tstepB = 2 * hstepB;
    const unsigned ldsw = (unsigned)wid * 1024u;
    const int aoff = lds_byte(wr * 64 + fr, fq * 8), boff = lds_byte(wc * 32 + fr, fq * 8);
#define PG8_SA(b, h) (((b) * 2 + (h)) * HTB)
#define PG8_SB(b, h) ((4 + (b) * 2 + (h)) * HTB)
#define PG8_STAGE(bufoff, gbase, voff) do { _Pragma("unroll") for (int _i = 0; _i < 2; ++_i) \
        __builtin_amdgcn_global_load_lds((const unsigned*)((const char*)(gbase) + (voff)[_i]), (PG8_LAS unsigned*)(lds + (bufoff) + ldsw + _i * 8192), 16, 0, 0); } while (0)
#define PG8_LDA(dst, b, h) do { _Pragma("unroll") for (int m = 0; m < 4; ++m) _Pragma("unroll") for (int k = 0; k < 2; ++k) dst[m][k] = *(const PG8_LAS bf16x8*)(lds + PG8_SA(b, h) + aoff + m * 2048 + k * 1024); } while (0)
#define PG8_LDB(dst, b, h) do { _Pragma("unroll") for (int n = 0; n < 2; ++n) _Pragma("unroll") for (int k = 0; k < 2; ++k) dst[n][k] = *(const PG8_LAS bf16x8*)(lds + PG8_SB(b, h) + boff + n * 2048 + k * 1024); } while (0)
#define PG8_MMA(ai, bj, At, Bt) do { __builtin_amdgcn_s_setprio(1); _Pragma("unroll") for (int m = 0; m < 4; ++m) _Pragma("unroll") for (int n = 0; n < 2; ++n) _Pragma("unroll") for (int k = 0; k < 2; ++k) \
        acc[ai][bj][m][n] = __builtin_amdgcn_mfma_f32_16x16x32_bf16(Bt[n][k], At[m][k], acc[ai][bj][m][n], 0, 0, 0); __builtin_amdgcn_s_setprio(0); } while (0)
#define PG8_WAIT_V(n) asm volatile("s_waitcnt vmcnt(" #n ")" ::: "memory")
#define PG8_WAIT_L(n) asm volatile("s_waitcnt lgkmcnt(" #n ")" ::: "memory")
#define PG8_BAR __builtin_amdgcn_s_barrier()
#define PG8_SCHED __builtin_amdgcn_sched_barrier(0)
    Unit cur, nxt; int ui = 0;
    if (!S.next(0, cur)) return;
    f32x4 acc[2][2][4][2];
#pragma unroll
    for (int a = 0; a < 2; ++a)
#pragma unroll
        for (int b = 0; b < 2; ++b)
#pragma unroll
            for (int m = 0; m < 4; ++m)
#pragma unroll
                for (int n = 0; n < 2; ++n) acc[a][b][m][n] = (f32x4){0.f, 0.f, 0.f, 0.f};
    bf16x8 At[4][2], B0[2][2], B1[2][2];
    const char* cA = (const char*)g.A + (size_t)cur.pm * tstepA; const char* cB = (const char*)g.Bt + (size_t)cur.pn * tstepB;
    S.a_ready(cur);
    if constexpr (SP2) {
        PG8_STAGE(PG8_SB(0, 0), cB, voffB); PG8_STAGE(PG8_SB(0, 1), cB + hstepB, voffB); PG8_STAGE(PG8_SA(0, 0), cA, voffA); PG8_STAGE(PG8_SA(0, 1), cA + hstepA, voffA);
        if (wr == 1) PG8_BAR;
        PG8_WAIT_V(2); PG8_BAR;
        PG8_STAGE(PG8_SB(1, 0), cB + kstep, voffB); PG8_STAGE(PG8_SA(1, 0), cA + kstep, voffA); PG8_STAGE(PG8_SB(1, 1), cB + hstepB + kstep, voffB);
        PG8_WAIT_V(6); PG8_BAR;
    } else {
        PG8_STAGE(PG8_SB(0, 0), cB, voffB); PG8_STAGE(PG8_SA(0, 0), cA, voffA); PG8_STAGE(PG8_SB(0, 1), cB + hstepB, voffB); PG8_STAGE(PG8_SA(0, 1), cA + hstepA, voffA);
        if (wr == 1) PG8_BAR;
        PG8_WAIT_V(4); PG8_BAR;
        PG8_STAGE(PG8_SB(1, 0), cB + kstep, voffB); PG8_STAGE(PG8_SA(1, 0), cA + kstep, voffA); PG8_STAGE(PG8_SB(1, 1), cB + hstepB + kstep, voffB);
        PG8_WAIT_V(6); PG8_BAR;
    }
    for (;;) {
        const bool has_next = S.next(ui + 1, nxt);
        const char* nA = has_next ? (const char*)g.A + (size_t)nxt.pm * tstepA : cA; const char* nB = has_next ? (const char*)g.Bt + (size_t)nxt.pn * tstepB : cB;
        for (int t = 0; t < nt; t += 2) {
            const bool last = (t == nt - 2);
            const char* a1 = cA + (size_t)(t + 1) * kstep;
            const char* a2 = last ? nA : cA + (size_t)(t + 2) * kstep; const char* b2 = last ? nB : cB + (size_t)(t + 2) * kstep;
            const char* a3 = a2 + kstep; const char* b3 = b2 + kstep;
            if (last && has_next) S.a_ready(nxt);
            if constexpr (SP2) {
            PG8_LDB(B0, 0, 0); PG8_LDB(B1, 0, 1); PG8_SCHED; PG8_LDA(At, 0, 0); PG8_STAGE(PG8_SA(1, 1), a1 + hstepA, voffA);
            PG8_WAIT_V(8); PG8_WAIT_L(0); PG8_BAR; PG8_MMA(0, 0, At, B0); PG8_MMA(0, 1, At, B1); PG8_BAR; PG8_SCHED;
            PG8_LDA(At, 0, 1); PG8_STAGE(PG8_SB(0, 0), b2, voffB); PG8_STAGE(PG8_SB(0, 1), b2 + hstepB, voffB); PG8_STAGE(PG8_SA(0, 0), a2, voffA);
            PG8_WAIT_V(8); PG8_WAIT_L(0); PG8_BAR; PG8_MMA(1, 0, At, B0); PG8_MMA(1, 1, At, B1); PG8_BAR; PG8_SCHED;
            PG8_LDB(B0, 1, 0); PG8_LDB(B1, 1, 1); PG8_SCHED; PG8_LDA(At, 1, 0); PG8_STAGE(PG8_SA(0, 1), a2 + hstepA, voffA);
            PG8_WAIT_V(8); PG8_WAIT_L(0); PG8_BAR; PG8_MMA(0, 0, At, B0); PG8_MMA(0, 1, At, B1); PG8_BAR; PG8_SCHED;
            PG8_LDA(At, 1, 1); PG8_STAGE(PG8_SB(1, 0), b3, voffB); PG8_STAGE(PG8_SB(1, 1), b3 + hstepB, voffB); PG8_STAGE(PG8_SA(1, 0), a3, voffA);
            PG8_WAIT_V(8); PG8_WAIT_L(0); PG8_BAR; PG8_MMA(1, 0, At, B0); PG8_MMA(1, 1, At, B1); PG8_BAR; PG8_SCHED;
            } else {
            PG8_LDB(B0, 0, 0); PG8_SCHED; PG8_LDA(At, 0, 0); PG8_STAGE(PG8_SA(1, 1), a1 + hstepA, voffA);
            PG8_WAIT_L(8); PG8_BAR; PG8_WAIT_L(0); PG8_MMA(0, 0, At, B0); PG8_BAR; PG8_SCHED;
            PG8_LDB(B1, 0, 1); PG8_STAGE(PG8_SB(0, 0), b2, voffB);
            PG8_BAR; PG8_WAIT_L(0); PG8_MMA(0, 1, At, B1); PG8_BAR;
            PG8_LDA(At, 0, 1); PG8_STAGE(PG8_SA(0, 0), a2, voffA);
            PG8_BAR; PG8_WAIT_L(0); PG8_MMA(1, 0, At, B0); PG8_BAR; PG8_SCHED;
            PG8_STAGE(PG8_SB(0, 1), b2 + hstepB, voffB);
            PG8_WAIT_V(6); PG8_BAR; PG8_MMA(1, 1, At, B1); PG8_BAR;
            PG8_LDB(B0, 1, 0); PG8_SCHED; PG8_LDA(At, 1, 0); PG8_STAGE(PG8_SA(0, 1), a2 + hstepA, voffA);
            PG8_WAIT_L(8); PG8_BAR; PG8_WAIT_L(0); PG8_MMA(0, 0, At, B0); PG8_BAR; PG8_SCHED;
            PG8_LDB(B1, 1, 1); PG8_STAGE(PG8_SB(1, 0), b3, voffB);
            PG8_BAR; PG8_WAIT_L(0); PG8_MMA(0, 1, At, B1); PG8_BAR;
            PG8_LDA(At, 1, 1); PG8_STAGE(PG8_SA(1, 0), a3, voffA);
            PG8_BAR; PG8_WAIT_L(0); PG8_MMA(1, 0, At, B0); PG8_BAR; PG8_SCHED;
            PG8_STAGE(PG8_SB(1, 1), b3 + hstepB, voffB);
            PG8_WAIT_V(6); PG8_BAR; PG8_MMA(1, 1, At, B1); PG8_BAR;
            }
        }
        if constexpr (ALIGN_EPI) { if (wr == 0) PG8_BAR; }
        if constexpr (!Epi::AFTER_DRAIN) { E(acc, cur, wr, wc, fr, fq); S.done(cur); }
        if (!has_next) break;
#pragma unroll
        for (int a = 0; a < 2; ++a)
#pragma unroll
            for (int b = 0; b < 2; ++b)
#pragma unroll
                for (int m = 0; m < 4; ++m)
#pragma unroll
                    for (int n = 0; n < 2; ++n) acc[a][b][m][n] = (f32x4){0.f, 0.f, 0.f, 0.f};
        cur = nxt; cA = nA; cB = nB; ++ui;
        if constexpr (ALIGN_EPI) { if (wr == 1) PG8_BAR; }
    }
    PG8_WAIT_V(0);
    if constexpr (!ALIGN_EPI) { if (wr == 0) PG8_BAR; }
    PG8_BAR;
    if constexpr (Epi::AFTER_DRAIN) { E.fused(acc, cur, wr, wc, fr, fq, lds, wid, lane); S.done(cur); }
#undef PG8_SA
#undef PG8_SB
#undef PG8_STAGE
#undef PG8_LDA
#undef PG8_LDB
#undef PG8_MMA
#undef PG8_WAIT_V
#undef PG8_WAIT_L
#undef PG8_BAR
#undef PG8_SCHED
}
}

constexpr int SC_QT = 0, SC_QH = 18432, SC_KT = 36864, SC_ST = 82944, SC_KH = 101376, SC_VT = 121856, SC_P = 132096, SC_LR = 142336, SC_TOT = 144384, SC_DEC = 146432;
static_assert(SC_DEC + 512 <= LDSCTL_OFF, "scan LDS map");
constexpr int RS128 = 288, RS64 = 160;
typedef float f32x2 __attribute__((ext_vector_type(2)));
__device__ __forceinline__ unsigned cvtpk(float lo, float hi) { unsigned r; asm volatile("v_cvt_pk_bf16_f32 %0, %1, %2" : "=v"(r) : "v"(lo), "v"(hi)); return r; }

__device__ __forceinline__ int scan_chunk_base(int ci, int dir, int b) {
    if (ci < 4) { const int cc = dir ? 3 - ci : ci; return MLAT + b * CTXL + cc * 64; }
    const int lc = dir ? 35 - ci : ci - 4; return b * SEQ + lc * 64;
}

#define EX2(x) __builtin_amdgcn_exp2f(x)
template <int I>
__device__ __forceinline__ void scan_b2(LAS unsigned char* lds, const f32x2 (&cj)[8], const f32x2 (&qv)[8], const f32x2 (&kv)[8], const f32x2 tot, const int k_, const int r_0, const int h, const bool lat) {
    const LAS f32x2* totp = (const LAS f32x2*)(lds + SC_TOT + k_ * 4);
    const f32x2 t0 = totp[0], t1 = totp[64], t2 = totp[128], t3 = totp[192];
    const f32x2 R1 = t0, R2 = t0 + t1, R3 = R2 + t2, R4 = R3 + t3;
    const f32x2 RI = I == 0 ? (f32x2){0.f, 0.f} : (I == 1 ? R1 : (I == 2 ? R2 : R3));
    const f32x2 RN = RI + tot;
    const f32x2 eRI = {EX2(RI.x), EX2(RI.y)};
    f32x2 e2 = {0.f, 0.f}, e3 = {0.f, 0.f};
    if (I == 0) e2 = (f32x2){EX2(R2.x - RN.x), EX2(R2.y - RN.y)};
    if (I <= 1) e3 = (f32x2){EX2(R3.x - RN.x), EX2(R3.y - RN.y)};
    const f32x2 e4 = {EX2(R4.x - RN.x), EX2(R4.y - RN.y)};
    if (I == 3 && h == 0) *(LAS f32x2*)(lds + SC_DEC + k_ * 4) = (f32x2){EX2(R4.x), EX2(R4.y)};
    unsigned kh0[4], kh1[4];
    LAS unsigned char* const wp = lds + r_0 * RS128 + k_ * 2;
#pragma unroll
    for (int j = 0; j < 8; ++j) {
        const f32x2 dd = tot - cj[j];
        const f32x2 gg = {EX2(dd.x), EX2(dd.y)};
        const f32x2 kg = kv[j] * gg, kh = kg * e4;
        const unsigned khv = cvtpk(kh.x, kh.y);
        if (j & 1) { kh0[j >> 1] |= khv << 16; kh1[j >> 1] |= khv & 0xffff0000u; } else { kh0[j >> 1] = khv & 0xffffu; kh1[j >> 1] = khv >> 16; }
        if (lat) {
            const f32x2 ec = {EX2(cj[j].x), EX2(cj[j].y)};
            const f32x2 einv = {EX2(fminf(-cj[j].x, 115.f)), EX2(fminf(-cj[j].y, 115.f))};
            const f32x2 qtv = qv[j] * ec, qhv = qtv * eRI, kd = kv[j] * einv;
            LAS unsigned char* const w = wp + j * RS128;
            *(LAS unsigned*)(w + SC_QT) = cvtpk(qtv.x, qtv.y);
            *(LAS unsigned*)(w + SC_QH) = cvtpk(qhv.x, qhv.y);
            *(LAS unsigned*)(w + SC_KT + (8 * I * (I + 1)) * RS128) = cvtpk(kd.x, kd.y);
            if (I <= 2) *(LAS unsigned*)(w + SC_KT + (8 * (I + 1) * (I + 2)) * RS128) = cvtpk(kg.x, kg.y);
            if (I == 0) { const f32x2 k2 = kg * e2; *(LAS unsigned*)(w + SC_KT + 48 * RS128) = cvtpk(k2.x, k2.y); }
            if (I <= 1) { const f32x2 k3 = kg * e3; *(LAS unsigned*)(w + SC_KT + 96 * RS128) = cvtpk(k3.x, k3.y); }
        }
    }
    *(LAS u32x4*)(lds + SC_KH + k_ * RS64 + r_0 * 2) = (u32x4){kh0[0], kh0[1], kh0[2], kh0[3]};
    *(LAS u32x4*)(lds + SC_KH + (k_ + 1) * RS64 + r_0 * 2) = (u32x4){kh1[0], kh1[1], kh1[2], kh1[3]};
}

__device__ __forceinline__ void phase3(const Params& p, LAS unsigned char* lds) {
    const int tid = threadIdx.x, lane = tid & 63, wave = __builtin_amdgcn_readfirstlane(tid >> 6), fr = lane & 15, fq = lane >> 4;
    const int I = wave >> 1, k0 = 64 * (wave & 1) + 2 * (lane & 31), h = lane >> 5, r0 = 16 * I + 8 * h;
    const bf16* PA = (const bf16*)(p.ws + WS_PA);
    bf16* O = (bf16*)p.out;
    for (int it = blockIdx.x; it < 256; it += gridDim.x) {
        const int vh = it & 1, b = (it >> 1) & 7, hh = (it >> 4) & 3, dir = (it >> 6) & 1, br = it >> 7;
        const int qcol = (br ? 2048 : 0) + hh * 128;
        const int fcol = br ? 2560 + hh * 128 : 1024 + dir * 512 + hh * 128;
        const int vcol = (br ? 3072 : 512) + hh * 128 + vh * 64;
        const int lrcol = 3584 + dir * 16;
        for (int e = tid; e < 18432 / 16; e += NTHREADS) *(LAS u32x4*)(lds + SC_ST + e * 16) = (u32x4){0u, 0u, 0u, 0u};
        for (int e = tid; e < 10240 / 16; e += NTHREADS) *(LAS u32x4*)(lds + SC_P + e * 16) = (u32x4){0u, 0u, 0u, 0u};
        f32x4 S[4];
#pragma unroll
        for (int j = 0; j < 4; ++j) S[j] = (f32x4){0.f, 0.f, 0.f, 0.f};
        f32x2 bg = {0.f, 0.f}; f32x2 wg[16];
#pragma unroll
        for (int r = 0; r < 16; ++r) wg[r] = (f32x2){0.f, 0.f};
        if (br) { bg = *(const f32x2*)(p.in[14] + dir * 512 + hh * 128 + k0) * 1.4426950408889634f;
#pragma unroll
            for (int r = 0; r < 16; ++r) wg[r] = *(const f32x2*)(p.in[13] + (size_t)(dir * 16 + r) * 512 + hh * 128 + k0) * 1.4426950408889634f; }
        unsigned pq[8], pf[8]; u32x4 pv, plr = {0u, 0u, 0u, 0u};
#define SCAN_PREFETCH(ci_) do { const int base_ = scan_chunk_base((ci_), dir, b); \
            if (br && tid < 128) { const int s_ = tid >> 1; plr = *(const u32x4*)(PA + (size_t)(base_ + (dir ? 63 - s_ : s_)) * NA + lrcol + 8 * (tid & 1)); } \
            _Pragma("unroll") for (int j = 0; j < 8; ++j) { const int r_ = r0 + j; const bf16* pr_ = PA + (size_t)(base_ + (dir ? 63 - r_ : r_)) * NA; pq[j] = *(const unsigned*)(pr_ + qcol + k0); pf[j] = *(const unsigned*)(pr_ + fcol + k0); } \
            { const int s_ = tid & 63; pv = *(const u32x4*)(PA + (size_t)(base_ + (dir ? 63 - s_ : s_)) * NA + vcol + (tid >> 6) * 8); } } while (0)
        SCAN_PREFETCH(0);
        __syncthreads();
#pragma unroll 1
        for (int ci = 0; ci < 36; ++ci) {
            int k_ = k0, fr_ = fr, fq_ = fq, r_0 = r0; asm volatile("" : "+v"(k_), "+v"(fr_), "+v"(fq_), "+v"(r_0));
            const bool lat = ci >= 4;
            if (br && tid < 128) *(LAS u32x4*)(lds + SC_LR + tid * 16) = plr;
            if (br) __syncthreads();
            f32x2 cj[8], qv[8], kv[8];
            if (br == 0) {
#pragma unroll
                for (int j = 0; j < 8; ++j) {
                    const f32x2 f = {bflo(pf[j]), bfhi(pf[j])};
                    cj[j] = (f32x2){__builtin_amdgcn_logf(f.x), __builtin_amdgcn_logf(f.y)}; kv[j] = 1.0f - f; qv[j] = (f32x2){bflo(pq[j]), bfhi(pq[j])};
                }
            } else {
#pragma unroll
                for (int j = 0; j < 8; ++j) {
                    const LAS u32x4* lp = (const LAS u32x4*)(lds + SC_LR + (r_0 + j) * 32);
                    const u32x4 l0 = lp[0], l1 = lp[1];
                    f32x2 x = bg;
                    x += bflo(l0.x) * wg[0] + bfhi(l0.x) * wg[1] + bflo(l0.y) * wg[2] + bfhi(l0.y) * wg[3];
                    x += bflo(l0.z) * wg[4] + bfhi(l0.z) * wg[5] + bflo(l0.w) * wg[6] + bfhi(l0.w) * wg[7];
                    x += bflo(l1.x) * wg[8] + bfhi(l1.x) * wg[9] + bflo(l1.y) * wg[10] + bfhi(l1.y) * wg[11];
                    x += bflo(l1.z) * wg[12] + bfhi(l1.z) * wg[13] + bflo(l1.w) * wg[14] + bfhi(l1.w) * wg[15];
                    const float ls0 = fminf(x.x, 0.f) - __builtin_amdgcn_logf(1.0f + __builtin_amdgcn_exp2f(-fabsf(x.x))), ls1 = fminf(x.y, 0.f) - __builtin_amdgcn_logf(1.0f + __builtin_amdgcn_exp2f(-fabsf(x.y)));
                    cj[j] = (f32x2){ls0 * (1.0f / 16.0f), ls1 * (1.0f / 16.0f)}; kv[j] = (f32x2){bflo(pf[j]), bfhi(pf[j])}; qv[j] = (f32x2){bflo(pq[j]), bfhi(pq[j])};
                }
            }
#pragma unroll
            for (int j = 1; j < 8; ++j) cj[j] += cj[j - 1];
            f32x2 tot;
            {
                const f32x2 oth = {__shfl_xor(cj[7].x, 32), __shfl_xor(cj[7].y, 32)};
                tot = cj[7] + oth;
                if (h) {
#pragma unroll
                    for (int j = 0; j < 8; ++j) cj[j] += oth;
                } else *(LAS f32x2*)(lds + SC_TOT + (I * 128 + k_) * 4) = tot;
            }
            {
                const int s_ = tid & 63, c8 = (tid >> 6) * 8;
                LAS bf16* vt = (LAS bf16*)(lds + SC_VT);
                const unsigned vw[4] = {pv.x, pv.y, pv.z, pv.w};
#pragma unroll
                for (int e = 0; e < 4; ++e) { vt[(c8 + 2 * e) * (RS64 / 2) + s_] = (bf16)(vw[e] & 0xffffu); vt[(c8 + 2 * e + 1) * (RS64 / 2) + s_] = (bf16)(vw[e] >> 16); }
            }
            if (ci + 1 < 36) SCAN_PREFETCH(ci + 1);
            __syncthreads();
            if (I == 0) scan_b2<0>(lds, cj, qv, kv, tot, k_, r_0, h, lat);
            else if (I == 1) scan_b2<1>(lds, cj, qv, kv, tot, k_, r_0, h, lat);
            else if (I == 2) scan_b2<2>(lds, cj, qv, kv, tot, k_, r_0, h, lat);
            else scan_b2<3>(lds, cj, qv, kv, tot, k_, r_0, h, lat);
            __syncthreads();
            const int I2 = wave >> 1, JcA = 2 * (wave & 1);
            f32x4 ao[2] = {{0.f, 0.f, 0.f, 0.f}, {0.f, 0.f, 0.f, 0.f}};
            if (lat) {
                for (int ti = wave; ti < 10; ti += 8) {
                    const int Ib = ti >= 6 ? 3 : (ti >= 3 ? 2 : (ti >= 1 ? 1 : 0)), Jb = ti - (Ib * (Ib + 1)) / 2, kbase = 8 * Ib * (Ib + 1);
                    f32x4 acc = {0.f, 0.f, 0.f, 0.f};
#pragma unroll
                    for (int ks = 0; ks < 4; ++ks) {
                        const bf16x8 qa = *(const LAS bf16x8*)(lds + SC_QT + (16 * Ib + fr_) * RS128 + (32 * ks + 8 * fq_) * 2);
                        const bf16x8 kb = *(const LAS bf16x8*)(lds + SC_KT + (kbase + 16 * Jb + fr_) * RS128 + (32 * ks + 8 * fq_) * 2);
                        acc = __builtin_amdgcn_mfma_f32_16x16x32_bf16(kb, qa, acc, 0, 0, 0);
                    }
                    if (Ib == Jb) {
#pragma unroll
                        for (int reg = 0; reg < 4; ++reg) acc[reg] = (4 * fq_ + reg <= fr_) ? acc[reg] : 0.f;
                    }
                    u32x2 w; w.x = cvtpk(acc[0], acc[1]); w.y = cvtpk(acc[2], acc[3]);
                    *(LAS u32x2*)(lds + SC_P + (16 * Ib + fr_) * RS64 + (16 * Jb + 4 * fq_) * 2) = w;
                }
#pragma unroll
                for (int ks = 0; ks < 4; ++ks) {
                    const bf16x8 qa = *(const LAS bf16x8*)(lds + SC_QH + (16 * I2 + fr_) * RS128 + (32 * ks + 8 * fq_) * 2);
#pragma unroll
                    for (int jj = 0; jj < 2; ++jj) {
                        const bf16x8 sb = *(const LAS bf16x8*)(lds + SC_ST + (16 * (JcA + jj) + fr_) * RS128 + (32 * ks + 8 * fq_) * 2);
                        ao[jj] = __builtin_amdgcn_mfma_f32_16x16x32_bf16(sb, qa, ao[jj], 0, 0, 0);
                    }
                }
            }
            {
                const f32x4 dec = *(const LAS f32x4*)(lds + SC_DEC + (16 * wave + 4 * fq_) * 4);
#pragma unroll
                for (int jc = 0; jc < 4; ++jc) S[jc] = S[jc] * dec;
#pragma unroll
                for (int ks = 0; ks < 2; ++ks) {
                    const bf16x8 a = *(const LAS bf16x8*)(lds + SC_KH + (16 * wave + fr_) * RS64 + (32 * ks + 8 * fq_) * 2);
#pragma unroll
                    for (int jc = 0; jc < 4; ++jc) {
                        const bf16x8 bb = *(const LAS bf16x8*)(lds + SC_VT + (16 * jc + fr_) * RS64 + (32 * ks + 8 * fq_) * 2);
                        S[jc] = __builtin_amdgcn_mfma_f32_16x16x32_bf16(a, bb, S[jc], 0, 0, 0);
                    }
                }
            }
            __syncthreads();
            {
                if (lat) {
                    const int nks = I2 < 2 ? 1 : 2;
                    for (int ks = 0; ks < nks; ++ks) {
                        const bf16x8 pa = *(const LAS bf16x8*)(lds + SC_P + (16 * I2 + fr_) * RS64 + (32 * ks + 8 * fq_) * 2);
#pragma unroll
                        for (int jj = 0; jj < 2; ++jj) {
                            const bf16x8 vb = *(const LAS bf16x8*)(lds + SC_VT + (16 * (JcA + jj) + fr_) * RS64 + (32 * ks + 8 * fq_) * 2);
                            ao[jj] = __builtin_amdgcn_mfma_f32_16x16x32_bf16(vb, pa, ao[jj], 0, 0, 0);
                        }
                    }
                    const int base = scan_chunk_base(ci, dir, b);
                    const int t = 16 * I2 + fr_; const size_t row = (size_t)(base + (dir ? 63 - t : t));
                    bf16* ob = O + ((size_t)(br * 2 + dir) * MLAT + row) * 512 + hh * 128 + vh * 64 + 4 * fq_;
#pragma unroll
                    for (int jj = 0; jj < 2; ++jj) { u32x2 w; w.x = cvtpk(ao[jj][0], ao[jj][1]); w.y = cvtpk(ao[jj][2], ao[jj][3]); *(u32x2*)(ob + 16 * (JcA + jj)) = w; }
                }
#pragma unroll
                for (int jc = 0; jc < 4; ++jc) {
                    u32x2 w; w.x = cvtpk(S[jc][0], S[jc][1]); w.y = cvtpk(S[jc][2], S[jc][3]);
                    *(LAS u32x2*)(lds + SC_ST + (16 * jc + fr_) * RS128 + (16 * wave + 4 * fq_) * 2) = w;
                }
            }
            __syncthreads();
        }
#undef SCAN_PREFETCH
    }
}

__device__ __forceinline__ void phase5(const Params& p) {
    const int tid = threadIdx.x, lane = tid & 63, wave = tid >> 6;
    const int gw = blockIdx.x * NWAVES + wave, NGW = gridDim.x * NWAVES;
    const bf16* O = (const bf16*)p.out; const bf16* PB = (const bf16*)(p.ws + WS_PA); bf16* A12 = (bf16*)(p.ws + WS_A12);
    for (int m = gw; m < MLAT; m += NGW) {
#pragma unroll
        for (int hd = 0; hd < 8; ++hd) {
            const int br = hd >> 2, col = (hd & 3) * 128 + 2 * lane;
            const unsigned a = *(const unsigned*)(O + ((size_t)(br * 2 + 0) * MLAT + m) * 512 + col), bq = *(const unsigned*)(O + ((size_t)(br * 2 + 1) * MLAT + m) * 512 + col);
            const float o0 = bflo(a) + bflo(bq), o1 = bfhi(a) + bfhi(bq);
            const float rstd = 1.0f / sqrtf(wave_sum(o0 * o0 + o1 * o1) * (1.0f / 128.0f) + EPS);
            const unsigned g = *(const unsigned*)(PB + (size_t)m * NBB + br * 512 + col);
            const float* on = (br ? p.in[15] : p.in[12]) + 2 * lane;
            const float r0 = o0 * rstd * on[0] * siluf_(bflo(g)), r1 = o1 * rstd * on[1] * siluf_(bfhi(g));
            *(unsigned*)(A12 + (size_t)m * D + hd * 128 + 2 * lane) = pk2(r0, r1);
        }
    }
}

__device__ __forceinline__ void phase8(const Params& p) {
    const int tid = threadIdx.x, lane = tid & 63, wave = tid >> 6;
    const int gw = blockIdx.x * NWAVES + wave, NGW = gridDim.x * NWAVES;
    const float* x = p.in[0]; const float* post1 = p.in[7]; const float* pre2 = p.in[8];
    const float* modv = (const float*)(p.ws + WS_MODV); const bf16* y1 = (const bf16*)(p.ws + WS_Y1); bf16* h2 = (bf16*)(p.ws + WS_H1);
    for (int m = gw; m < MLAT; m += NGW) {
        const float* mv = modv + (size_t)(m / SEQ) * NMOD;
        f32x4 y[4], z[4]; float ss = 0.f;
#pragma unroll
        for (int j = 0; j < 4; ++j) {
            const u32x2 w = *(const u32x2*)(y1 + (size_t)m * D + 4 * lane + 256 * j);
            y[j] = (f32x4){bflo(w.x), bfhi(w.x), bflo(w.y), bfhi(w.y)};
            ss += (y[j][0] * y[j][0] + y[j][1] * y[j][1]) + (y[j][2] * y[j][2] + y[j][3] * y[j][3]);
        }
        const float rstd1 = 1.0f / sqrtf(wave_sum(ss) * (1.0f / D) + EPS);
        float s2 = 0.f;
#pragma unroll
        for (int j = 0; j < 4; ++j) {
            const int col = 4 * lane + 256 * j;
            const f32x4 xv = *(const f32x4*)(x + (size_t)m * D + col), w = *(const f32x4*)(post1 + col), g = *(const f32x4*)(mv + 2048 + col);
#pragma unroll
            for (int e = 0; e < 4; ++e) { z[j][e] = xv[e] + g[e] * (y[j][e] * rstd1 * w[e]); s2 += z[j][e] * z[j][e]; }
            *(f32x4*)(p.out + (size_t)m * D + col) = z[j];
        }
        const float rstdz = 1.0f / sqrtf(wave_sum(s2) * (1.0f / D) + EPS);
#pragma unroll
        for (int j = 0; j < 4; ++j) {
            const int col = 4 * lane + 256 * j;
            const f32x4 w = *(const f32x4*)(pre2 + col), sh = *(const f32x4*)(mv + 3072 + col), sc = *(const f32x4*)(mv + 4096 + col);
            f32x4 h;
#pragma unroll
            for (int e = 0; e < 4; ++e) h[e] = z[j][e] * rstdz * w[e] * (1.0f + sc[e]) + sh[e];
            u32x2 o; o.x = pk2(h[0], h[1]); o.y = pk2(h[2], h[3]);
            *(u32x2*)(h2 + (size_t)m * D + col) = o;
        }
    }
}

__device__ __forceinline__ void phase11(const Params& p) {
    const int tid = threadIdx.x, lane = tid & 63, wave = tid >> 6;
    const int gw = blockIdx.x * NWAVES + wave, NGW = gridDim.x * NWAVES;
    const float* post2 = p.in[9];
    const float* modv = (const float*)(p.ws + WS_MODV); const bf16* y2 = (const bf16*)(p.ws + WS_A12);
    for (int m = gw; m < MLAT; m += NGW) {
        const float* mv = modv + (size_t)(m / SEQ) * NMOD;
        f32x4 y[4]; float ss = 0.f;
#pragma unroll
        for (int j = 0; j < 4; ++j) {
            const u32x2 w = *(const u32x2*)(y2 + (size_t)m * D + 4 * lane + 256 * j);
            y[j] = (f32x4){bflo(w.x), bfhi(w.x), bflo(w.y), bfhi(w.y)};
            ss += (y[j][0] * y[j][0] + y[j][1] * y[j][1]) + (y[j][2] * y[j][2] + y[j][3] * y[j][3]);
        }
        const float rstd2 = 1.0f / sqrtf(wave_sum(ss) * (1.0f / D) + EPS);
#pragma unroll
        for (int j = 0; j < 4; ++j) {
            const int col = 4 * lane + 256 * j;
            const f32x4 w = *(const f32x4*)(post2 + col), g = *(const f32x4*)(mv + 5120 + col);
            f32x4 z = *(const f32x4*)(p.out + (size_t)m * D + col);
#pragma unroll
            for (int e = 0; e < 4; ++e) z[e] += g[e] * (y[j][e] * rstd2 * w[e]);
            *(f32x4*)(p.out + (size_t)m * D + col) = z;
        }
    }
}


#define GAS __attribute__((address_space(1)))
typedef GAS unsigned gu32;
#define RLX_AGENT __ATOMIC_RELAXED, __HIP_MEMORY_SCOPE_AGENT
#define XB_TMO      128
#define XB_XCNT(j)  (256  + 64 * (j))
#define XB_XSUB(j)  (1280 + 64 * (j))
#define XB_XGEN(j)  (2304 + 64 * (j))
#define XB_TOP      3328
#define XB_TOPGEN   3392
#define XCD_BAR_WORDS 3456
#define XB_SPIN_CAP (1u << 18)

__device__ __forceinline__ unsigned xb_ld(unsigned* p)              { return __hip_atomic_load(p, __ATOMIC_RELAXED, __HIP_MEMORY_SCOPE_AGENT); }
__device__ __forceinline__ unsigned xb_add(unsigned* p, unsigned v) { return __hip_atomic_fetch_add(p, v, __ATOMIC_RELAXED, __HIP_MEMORY_SCOPE_AGENT); }
__device__ __forceinline__ unsigned xb_xcc_id() { return (unsigned)__builtin_amdgcn_s_getreg((3 << 11) | 20) & 0xFu; }
#define XB_SPIN(cond, bar) do { unsigned _sp = 0; while (cond) { __builtin_amdgcn_s_sleep(1); \
    if ((++_sp & 255u) == 0u) { if (xb_ld(&(bar)[XB_TMO])) break; if (_sp > XB_SPIN_CAP) { atomicAdd(&(bar)[XB_TMO], 1u); break; } } } } while (0)

struct XcdBarrier {
    unsigned* bar; unsigned x;
    volatile LAS unsigned* st;
};

__device__ __forceinline__ XcdBarrier xcd_barrier_post(unsigned* bar, volatile LAS unsigned* st) {
    XcdBarrier b; b.bar = bar; b.x = xb_xcc_id(); b.st = st;
    if (threadIdx.x == 0) (void)xb_add(&bar[XB_XCNT(b.x)], 1u);
    return b;
}
__device__ __forceinline__ void xcd_barrier_complete(unsigned* bar, unsigned x, unsigned& nloc, unsigned& nx) {
    const unsigned G = gridDim.x * gridDim.y * gridDim.z;
    unsigned sum, cnt, mine, sp = 0u;
    for (;;) {
        sum = 0u; cnt = 0u; mine = 0u;
#pragma unroll
        for (unsigned j = 0; j < 16; ++j) { const unsigned c = xb_ld(&bar[XB_XCNT(j)]); sum += c; cnt += (c > 0u) ? 1u : 0u; mine = (j == x) ? c : mine; }
        if (sum == G) break;
        __builtin_amdgcn_s_sleep(1);
        if ((++sp & 255u) == 0u) { if (xb_ld(&bar[XB_TMO])) break; if (sp > XB_SPIN_CAP) { atomicAdd(&bar[XB_TMO], 1u); break; } }
    }
    nloc = mine > 0u ? mine : 1u; nx = cnt > 0u ? cnt : 1u;
}

__device__ __forceinline__ void xcd_barrier(const XcdBarrier& b) {
    asm volatile("s_waitcnt vmcnt(0)" ::: "memory");
    __syncthreads();
    if (threadIdx.x == 0) {
        unsigned* bar = b.bar;
        __builtin_amdgcn_s_waitcnt(0);
        unsigned nloc = b.st[0], nx = b.st[1];
        if (nloc == 0u) { xcd_barrier_complete(bar, b.x, nloc, nx); b.st[0] = nloc; b.st[1] = nx; }
        const unsigned old = xb_add(&bar[XB_XSUB(b.x)], 1u);
        const unsigned gen = old / nloc;
        if (old + 1u == (gen + 1u) * nloc) {
            __builtin_amdgcn_fence(__ATOMIC_RELEASE, "agent");
            asm volatile("s_waitcnt vmcnt(0)" ::: "memory");
            const unsigned og = xb_add(&bar[XB_TOP], 1u);
            const unsigned tg = og / nx;
            if (og + 1u == (tg + 1u) * nx) xb_add(&bar[XB_TOPGEN], 1u);
            else XB_SPIN(xb_ld(&bar[XB_TOPGEN]) == tg, bar);
            __builtin_amdgcn_fence(__ATOMIC_ACQUIRE, "agent");
            xb_add(&bar[XB_XGEN(b.x)], 1u);
            asm volatile("s_waitcnt vmcnt(0)" ::: "memory");
        } else {
            XB_SPIN(xb_ld(&bar[XB_XGEN(b.x)]) == gen, bar);
            __builtin_amdgcn_fence(__ATOMIC_ACQUIRE, "agent");
            asm volatile("s_waitcnt vmcnt(0)" ::: "memory");
        }
    }
    __syncthreads();
}

__global__ void __launch_bounds__(NTHREADS, 2) fwd_kernel(Params p) {
    extern __shared__ __attribute__((aligned(16))) unsigned char lds_raw[];
    LAS unsigned char* lds = (LAS unsigned char*)lds_raw;
    for (int u = threadIdx.x; u < (LDS_BYTES - LDSCTL_OFF) / 4; u += NTHREADS) ((LAS unsigned*)(lds + LDSCTL_OFF))[u] = 0u;
    __syncthreads();
    const XcdBarrier bar = xcd_barrier_post((unsigned*)(p.ws + WS_CTL), (volatile LAS unsigned*)(lds + LDSCTL_OFF) + 8);
    unsigned char* ws = p.ws;
    const int lo = p.ph_lo, hi = p.ph_hi;
#ifndef DUP_MASK
#define DUP_MASK 0
#endif
#ifndef PHASE_MASK
#define PHASE_MASK 0xFFF
#endif
#define IN(k) ((((PHASE_MASK) >> (k)) & 1) && lo <= (k) && (k) < hi)
#define SYNC(k) do { if (IN(k) && IN((k) + 1)) xcd_barrier(bar); } while (0)
    if (IN(0)) for (int rep_ = 0; rep_ < 1 + (((DUP_MASK) >> 0) & 1); ++rep_) { if (rep_) xcd_barrier(bar);
        phase0(p, lds);
    }
    SYNC(0);
    if (IN(1)) for (int rep_ = 0; rep_ < 1 + (((DUP_MASK) >> 1) & 1); ++rep_) { if (rep_) xcd_barrier(bar);
        phase1(p);
    }
    SYNC(1);
    if (IN(2)) for (int rep_ = 0; rep_ < 1 + (((DUP_MASK) >> 2) & 1); ++rep_) { if (rep_) xcd_barrier(bar);
        { pg8::Gemm g{(const bf16*)(ws + WS_H1), (const bf16*)(ws + WS_WA), MALL, NA, D, D}; pg8::StaticOrder S; S.init(MALL, NA, (int)gridDim.x, (int)blockIdx.x);
        pg8::EpiProjA e{(bf16*)(ws + WS_PA), NA, (const float*)(ws + WS_LB)}; pg8::gemm_phase<pg8::EpiProjA, pg8::StaticOrder, true, true>(lds, g, S, e); }
    }
    SYNC(2);
    if (IN(3)) for (int rep_ = 0; rep_ < 1 + (((DUP_MASK) >> 3) & 1); ++rep_) { if (rep_) xcd_barrier(bar);
        phase3(p, lds);
    }
    SYNC(3);
    if (IN(4)) for (int rep_ = 0; rep_ < 1 + (((DUP_MASK) >> 4) & 1); ++rep_) { if (rep_) xcd_barrier(bar);
        { pg8::Gemm g{(const bf16*)(ws + WS_H1), (const bf16*)(ws + WS_WB), MLAT, NBB, D, D}; pg8::StaticOrder S; S.init(MLAT, NBB, (int)gridDim.x, (int)blockIdx.x);
        pg8::EpiStoreBf16 e{(bf16*)(ws + WS_PA), NBB}; pg8::gemm_phase<pg8::EpiStoreBf16, pg8::StaticOrder, true, true>(lds, g, S, e); }
    }
    SYNC(4);
    if (IN(5)) for (int rep_ = 0; rep_ < 1 + (((DUP_MASK) >> 5) & 1); ++rep_) { if (rep_) xcd_barrier(bar);
        phase5(p);
    }
    SYNC(5);
    if (IN(6)) for (int rep_ = 0; rep_ < 1 + (((DUP_MASK) >> 6) & 1); ++rep_) { if (rep_) xcd_barrier(bar);
        {
        pg8::StaticOrder S; S.init(MLAT, D, (int)gridDim.x, (int)blockIdx.x);
        { pg8::Gemm g{(const bf16*)(ws + WS_A12), (const bf16*)(ws + WS_WBRH), MLAT, D, 512, D};
          pg8::EpiBranch<0> e{(bf16*)(ws + WS_H1), D, (const bf16*)(ws + WS_PA), NBB, 1024}; pg8::gemm_phase<pg8::EpiBranch<0>, pg8::StaticOrder, true, true>(lds, g, S, e); }
        { pg8::Gemm g{(const bf16*)(ws + WS_A12) + 512, (const bf16*)(ws + WS_WBRG), MLAT, D, 512, D};
          pg8::EpiBranch<1> e{(bf16*)(ws + WS_H1), D, (const bf16*)(ws + WS_PA), NBB, 2048}; pg8::gemm_phase<pg8::EpiBranch<1>, pg8::StaticOrder, true, true>(lds, g, S, e); }
    }
    }
    SYNC(6);
    if (IN(7)) for (int rep_ = 0; rep_ < 1 + (((DUP_MASK) >> 7) & 1); ++rep_) { if (rep_) xcd_barrier(bar);
        { pg8::Gemm g{(const bf16*)(ws + WS_H1), (const bf16*)(ws + WS_WOUT), MLAT, D, D, D}; pg8::StaticOrder S; S.init(MLAT, D, (int)gridDim.x, (int)blockIdx.x);
        pg8::EpiStoreBf16 e{(bf16*)(ws + WS_Y1), D}; pg8::gemm_phase<pg8::EpiStoreBf16, pg8::StaticOrder, true, true>(lds, g, S, e); }
    }
    SYNC(7);
    if (IN(8)) for (int rep_ = 0; rep_ < 1 + (((DUP_MASK) >> 8) & 1); ++rep_) { if (rep_) xcd_barrier(bar);
        phase8(p);
    }
    SYNC(8);
    if (IN(9)) for (int rep_ = 0; rep_ < 1 + (((DUP_MASK) >> 9) & 1); ++rep_) { if (rep_) xcd_barrier(bar);
        { pg8::Gemm g{(const bf16*)(ws + WS_H1), (const bf16*)(ws + WS_WGU), MLAT, NGU, D, D}; pg8::StaticOrder S; S.init(MLAT, NGU, (int)gridDim.x, (int)blockIdx.x);
        pg8::EpiSwiGLU e{(bf16*)(ws + WS_PA), DFF}; pg8::gemm_phase<pg8::EpiSwiGLU, pg8::StaticOrder, true, true>(lds, g, S, e); }
    }
    SYNC(9);
    if (IN(10)) for (int rep_ = 0; rep_ < 1 + (((DUP_MASK) >> 10) & 1); ++rep_) { if (rep_) xcd_barrier(bar);
        { pg8::Gemm g{(const bf16*)(ws + WS_PA), (const bf16*)(ws + WS_WD), MLAT, D, DFF, DFF}; pg8::StaticOrder S; S.init(MLAT, D, (int)gridDim.x, (int)blockIdx.x);
        pg8::EpiStoreBf16 e{(bf16*)(ws + WS_A12), D}; pg8::gemm_phase<pg8::EpiStoreBf16, pg8::StaticOrder, true, true>(lds, g, S, e); }
    }
    SYNC(10);
    if (IN(11)) for (int rep_ = 0; rep_ < 1 + (((DUP_MASK) >> 11) & 1); ++rep_) { if (rep_) xcd_barrier(bar);
        phase11(p);
    }
#undef IN
#undef SYNC
}

extern "C" void kernel_launch(void* const* d_in, const int* in_sizes, int n_in, void* d_out, int out_size, void* d_ws, size_t ws_size, hipStream_t stream) {
    static int grid = 0;
    if (grid == 0) {
        if (n_in != 22 || out_size != MLAT * D || ws_size < WS_END) { fprintf(stderr, "kernel_launch: unexpected shapes (n_in %d out %d ws %zu)\n", n_in, out_size, ws_size); grid = -1; return; }
        int dev = 0, cus = 0, per_cu = 0;
        hipGetDevice(&dev);
        hipDeviceGetAttribute(&cus, hipDeviceAttributeMultiprocessorCount, dev);
        hipFuncSetAttribute((const void*)fwd_kernel, hipFuncAttributeMaxDynamicSharedMemorySize, LDS_BYTES);
        hipOccupancyMaxActiveBlocksPerMultiprocessor(&per_cu, (const void*)fwd_kernel, NTHREADS, LDS_BYTES);
        if (per_cu < 1) { fprintf(stderr, "kernel_launch: occupancy query says %d blocks/CU\n", per_cu); per_cu = 1; }
        grid = cus * 1;
        (void)hipGetLastError();
    }
    if (grid < 0) return;
    Params p{};
    for (int i = 0; i < 22; ++i) p.in[i] = (const float*)d_in[i];
    p.out = (float*)d_out; p.ws = (unsigned char*)d_ws; p.ph_lo = 0; p.ph_hi = 12;
    if (hipMemsetAsync((char*)d_ws + WS_CTL, 0, CTL_ZERO_BYTES, stream) != hipSuccess) { fprintf(stderr, "kernel_launch: memset of the control words failed\n"); return; }
    hipLaunchKernelGGL(fwd_kernel, dim3(grid), dim3(NTHREADS), LDS_BYTES, stream, p);
    const hipError_t le = hipPeekAtLastError();
    if (le != hipSuccess) fprintf(stderr, "kernel_launch: launch failed: %s (grid %d)\n", hipGetErrorName(le), grid);
}
```
